# Optimizing an MI355X kernel written in HIP

```python
import jax, jax.numpy as jnp
from jax import lax
import numpy as np

D_MODEL = 1024
BATCH = 16
SEQ = 4096
DEPTH = 1
DEC_BATCH = 8
DEC_SEQ = 16
PAST_LEN = 1024

CHUNK = 64
HEAD_DIM = 64
A_Q_HEADS = 8
A_KV_HEADS = 2
A_WINDOW = 128
A_PREV_CHUNKS = A_WINDOW // CHUNK
B_HEADS = 8
B_PREV_CHUNKS = 8
B_REACH = B_PREV_CHUNKS * CHUNK
REL_CLIP = 128
ROPE_THETA = 10000.0
D_FF = 2816
CONV_WIDTH = 3
RMS_EPS = 1e-6
NEG_INF = -1e30
A_Q_W = A_Q_HEADS * HEAD_DIM
A_KV_W = A_KV_HEADS * HEAD_DIM
B_W = B_HEADS * HEAD_DIM
IN_SPLITS = (A_Q_W, A_KV_W, A_KV_W, B_W, B_W, B_W, D_MODEL, D_MODEL)
IN_WIDTH = A_Q_W + 2 * A_KV_W + 3 * B_W + 2 * D_MODEL

kernel_name = "hybrid_stream_swa_sink_chunkrel_convglu"


def rms_norm(x, g):
    xf = x.astype(jnp.float32)
    y = xf * lax.rsqrt(jnp.mean(xf * xf, axis=-1, keepdims=True) + RMS_EPS)
    return (y * g.astype(jnp.float32)).astype(x.dtype)


def rope(x, pos):
    half = HEAD_DIM // 2
    inv = 1.0 / (ROPE_THETA ** (jnp.arange(half, dtype=jnp.float32) * (2.0 / HEAD_DIM)))
    ang = pos.astype(jnp.float32)[:, None] * inv[None, :]
    cos = jnp.cos(ang)[:, None, :]
    sin = jnp.sin(ang)[:, None, :]
    xf = x.astype(jnp.float32)
    x1, x2 = xf[..., :half], xf[..., half:]
    return jnp.concatenate([x1 * cos - x2 * sin, x2 * cos + x1 * sin], axis=-1).astype(x.dtype)


def attend(q, k, v, valid, rel, sink, rel_table):
    b, lq, hq, hd = q.shape
    hkv = k.shape[2]
    r = hq // hkv
    qg = q.reshape(b, lq, hkv, r, hd)
    s = jnp.einsum("bqgrd,bkgd->bgrqk", qg, k, preferred_element_type=jnp.float32) * (hd ** -0.5)
    if rel_table is not None:
        idx = jnp.clip(rel, -REL_CLIP, REL_CLIP) + REL_CLIP
        bias = jnp.take(rel_table.astype(jnp.float32), idx, axis=1)
        s = s + bias.reshape(hkv, r, lq, -1)[None]
    if valid is not None:
        s = jnp.where(valid, s, NEG_INF)
    if sink is not None:
        sk = jnp.broadcast_to(sink.astype(jnp.float32).reshape(1, hkv, r, 1, 1), s.shape[:-1] + (1,))
        p = jax.nn.softmax(jnp.concatenate([s, sk], axis=-1), axis=-1)[..., :-1]
    else:
        p = jax.nn.softmax(s, axis=-1)
    o = jnp.einsum("bgrqk,bkgd->bqgrd", p.astype(v.dtype), v)
    return o.reshape(b, lq, hq, hd)


def chunk_band_attention(q, k, v, n_prev, sink=None, rel_table=None):
    b, s_len, hq, hd = q.shape
    nc = s_len // CHUNK
    pad = n_prev * CHUNK
    band = pad + CHUNK
    kp = jnp.pad(k, ((0, 0), (pad, 0), (0, 0), (0, 0)))
    vp = jnp.pad(v, ((0, 0), (pad, 0), (0, 0), (0, 0)))
    kpos = jnp.arange(band) - pad
    rel = kpos[None, :] - jnp.arange(CHUNK)[:, None]
    qc = jnp.moveaxis(q.reshape(b, nc, CHUNK, hq, hd), 1, 0)

    def one_chunk(args):
        c, qb = args
        start = c * CHUNK
        kb = lax.dynamic_slice_in_dim(kp, start, band, axis=1)
        vb = lax.dynamic_slice_in_dim(vp, start, band, axis=1)
        valid = (start + kpos) >= 0
        return attend(qb, kb, vb, valid, rel, sink, rel_table)

    out = lax.map(one_chunk, (jnp.arange(nc), qc))
    return jnp.moveaxis(out, 0, 1).reshape(b, s_len, hq, hd)


def layer(x, start, cache_a_k, cache_a_v, cache_b_k, cache_b_v, conv_state,
          g_mix_pre, w_in, sinks, rel_bias, w_oa, w_ob, w_out, g_mix_post,
          g_ffn_pre, w_up, conv_w, conv_b, w_down, g_ffn_post):
    bsz, t, _ = x.shape
    h = rms_norm(x, g_mix_pre)
    offs = [int(o) for o in np.cumsum(IN_SPLITS)[:-1]]
    qa, ka, va, qb, kb, vb, ga, gb = jnp.split(h @ w_in, offs, axis=-1)
    qa = qa.reshape(bsz, t, A_Q_HEADS, HEAD_DIM)
    ka = ka.reshape(bsz, t, A_KV_HEADS, HEAD_DIM)
    va = va.reshape(bsz, t, A_KV_HEADS, HEAD_DIM)
    qb = qb.reshape(bsz, t, B_HEADS, HEAD_DIM)
    kb = kb.reshape(bsz, t, B_HEADS, HEAD_DIM)
    vb = vb.reshape(bsz, t, B_HEADS, HEAD_DIM)
    pos = start + jnp.arange(t)
    qa = rope(qa, pos)
    ka = rope(ka, pos)
    if cache_a_k is None:
        oa = chunk_band_attention(qa, ka, va, A_PREV_CHUNKS, sink=sinks)
        ob = chunk_band_attention(qb, kb, vb, B_PREV_CHUNKS, rel_table=rel_bias)
        keep_a = min(A_WINDOW, t)
        keep_b = min(B_REACH, t)
        new_rows = (ka[:, t - keep_a:], va[:, t - keep_a:], kb[:, t - keep_b:], vb[:, t - keep_b:])
        conv_prev = jnp.zeros((bsz, CONV_WIDTH - 1, D_FF), x.dtype)
    else:
        oa = attend(qa, jnp.concatenate([cache_a_k, ka], axis=1),
                    jnp.concatenate([cache_a_v, va], axis=1), None, None, sinks, None)
        lb = cache_b_k.shape[1]
        kpos = jnp.concatenate([jnp.arange(lb) - lb, jnp.arange(t)])
        rel = kpos[None, :] - jnp.arange(t)[:, None]
        ob = attend(qb, jnp.concatenate([cache_b_k, kb], axis=1),
                    jnp.concatenate([cache_b_v, vb], axis=1), None, rel, None, rel_bias)
        new_rows = (ka, va, kb, vb)
        conv_prev = conv_state.astype(x.dtype)
    mixed = (jax.nn.sigmoid(ga) * (oa.reshape(bsz, t, A_Q_W) @ w_oa)
             + jax.nn.sigmoid(gb) * (ob.reshape(bsz, t, B_W) @ w_ob))
    x = x + rms_norm(mixed @ w_out, g_mix_post)
    h = rms_norm(x, g_ffn_pre)
    u, val = jnp.split(h @ w_up, 2, axis=-1)
    up = jnp.concatenate([conv_prev, u], axis=1)
    conv = conv_b
    for j in range(CONV_WIDTH):
        conv = conv + up[:, j:j + t] * conv_w[j]
    new_conv = up[:, t:]
    ff = (jax.nn.gelu(conv, approximate=False) * val) @ w_down
    x = x + rms_norm(ff, g_ffn_post)
    return x, new_rows + (new_conv,)


def setup_inputs(seed: int = 0) -> dict:
    key = jax.random.key(seed)
    ks = jax.random.split(key, 24)

    def nrm(k, shape, scale):
        return jax.random.normal(k, shape, jnp.float32) * scale

    a_rows = min(A_WINDOW, PAST_LEN)
    b_rows = min(B_REACH, PAST_LEN)
    return {
        "x_prompt": nrm(ks[0], (BATCH, SEQ, D_MODEL), 1.0),
        "x_sample": nrm(ks[1], (DEC_BATCH, DEC_SEQ, D_MODEL), 1.0),
        "cache_a_k": nrm(ks[2], (DEPTH, DEC_BATCH, a_rows, A_KV_HEADS, HEAD_DIM), 1.0),
        "cache_a_v": nrm(ks[3], (DEPTH, DEC_BATCH, a_rows, A_KV_HEADS, HEAD_DIM), 1.0),
        "cache_b_k": nrm(ks[4], (DEPTH, DEC_BATCH, b_rows, B_HEADS, HEAD_DIM), 1.0),
        "cache_b_v": nrm(ks[5], (DEPTH, DEC_BATCH, b_rows, B_HEADS, HEAD_DIM), 1.0),
        "state_conv": nrm(ks[6], (DEPTH, DEC_BATCH, CONV_WIDTH - 1, D_FF), 1.0),
        "g_mix_pre": 1.0 + nrm(ks[7], (DEPTH, D_MODEL), 0.1),
        "w_in": nrm(ks[8], (DEPTH, D_MODEL, IN_WIDTH), D_MODEL ** -0.5),
        "sinks": nrm(ks[9], (DEPTH, A_Q_HEADS), 1.0),
        "rel_bias": nrm(ks[10], (DEPTH, B_HEADS, 2 * REL_CLIP + 1), 0.5),
        "w_oa": nrm(ks[11], (DEPTH, A_Q_W, D_MODEL), A_Q_W ** -0.5),
        "w_ob": nrm(ks[12], (DEPTH, B_W, D_MODEL), B_W ** -0.5),
        "w_out": nrm(ks[13], (DEPTH, D_MODEL, D_MODEL), D_MODEL ** -0.5),
        "g_mix_post": 1.0 + nrm(ks[14], (DEPTH, D_MODEL), 0.1),
        "g_ffn_pre": 1.0 + nrm(ks[15], (DEPTH, D_MODEL), 0.1),
        "w_up": nrm(ks[16], (DEPTH, D_MODEL, 2 * D_FF), D_MODEL ** -0.5),
        "conv_w": nrm(ks[17], (DEPTH, CONV_WIDTH, D_FF), CONV_WIDTH ** -0.5),
        "conv_b": nrm(ks[18], (DEPTH, D_FF), 0.02),
        "w_down": nrm(ks[19], (DEPTH, D_FF, D_MODEL), D_FF ** -0.5),
        "g_ffn_post": 1.0 + nrm(ks[20], (DEPTH, D_MODEL), 0.1),
    }


def reference(x_prompt, x_sample, cache_a_k, cache_a_v, cache_b_k, cache_b_v, state_conv,
              g_mix_pre, w_in, sinks, rel_bias, w_oa, w_ob, w_out, g_mix_post,
              g_ffn_pre, w_up, conv_w, conv_b, w_down, g_ffn_post):
    yp = x_prompt
    ys = x_sample
    new_p = []
    new_s = []
    for l in range(DEPTH):
        w = (g_mix_pre[l], w_in[l], sinks[l], rel_bias[l], w_oa[l], w_ob[l], w_out[l],
             g_mix_post[l], g_ffn_pre[l], w_up[l], conv_w[l], conv_b[l], w_down[l], g_ffn_post[l])
        yp, sp = layer(yp, 0, None, None, None, None, None, *w)
        ys, ss = layer(ys, PAST_LEN, cache_a_k[l], cache_a_v[l], cache_b_k[l], cache_b_v[l],
                       state_conv[l], *w)
        new_p.append(sp)
        new_s.append(ss)

    def stack(lst, i):
        return jnp.stack([s[i] for s in lst], axis=0)

    return (yp, ys,
            stack(new_p, 0), stack(new_p, 1), stack(new_p, 2), stack(new_p, 3), stack(new_p, 4),
            stack(new_s, 0), stack(new_s, 1), stack(new_s, 2), stack(new_s, 3), stack(new_s, 4))
```

```cpp
#include <hip/hip_runtime.h>
#include <cstdio>
#include <cstdint>
#include <cmath>

#ifndef REPEAT_MASK
#define REPEAT_MASK 0
#endif
#ifndef PROBE_SUB_N
#define PROBE_SUB_N 0
#define PROBE_SUB_O 0
#endif
#ifndef PROBE_P4
#define PROBE_P4 0
#endif
#ifndef PROBE_SMP
#define PROBE_SMP 0
#endif
#ifndef PROBE_XBAR
#define PROBE_XBAR 0
#endif
#ifndef PROBE_NOEPI
#define PROBE_NOEPI 0
#endif
#ifndef ROUND_SYNC
#define ROUND_SYNC 0
#endif
#ifndef REPEAT_ATT
#define REPEAT_ATT 0
#endif
#define LAS __attribute__((address_space(3)))
#define GAS __attribute__((address_space(1)))
typedef unsigned short bf16_t;
typedef short bf16x8 __attribute__((ext_vector_type(8)));
typedef short s16x4 __attribute__((ext_vector_type(4)));
typedef float f32x2 __attribute__((ext_vector_type(2)));
typedef float f32x4 __attribute__((ext_vector_type(4)));
typedef float f32x16 __attribute__((ext_vector_type(16)));
typedef unsigned u32x2 __attribute__((ext_vector_type(2)));
typedef unsigned u32x4 __attribute__((ext_vector_type(4)));

constexpr int DM = 1024, NBATCH = 16, SEQ = 4096, MP = NBATCH * SEQ;
constexpr int SB = 8, ST = 16, MS = SB * ST, PAST = 1024;
constexpr int MROWS = MP + 256;
constexpr int FF = 2816, NIN = 4352, NUP = 2 * FF;
constexpr int GTP = 2880;
constexpr int SKVR = 576, SKVP = 1280;
constexpr int QKVP = 2304, GP = 2176;
constexpr size_t H_QA = 0, H_KA = H_QA + (size_t)MP * 512, H_VA = H_KA + (size_t)MP * 128, H_QB = H_VA + (size_t)MP * 128, H_KB = H_QB + (size_t)MP * 512, H_VB = H_KB + (size_t)MP * 512;
__host__ __device__ __forceinline__ size_t hm_off(int nheads, int b, int head, int t) { return (((size_t)b * nheads + head) * SEQ + t) * 64; }
constexpr int SQP = 1024;
constexpr int AP = 1088;
constexpr float EPS = 1e-6f;
constexpr float LOG2E = 1.4426950408889634f;
constexpr float C2 = 0.125f * LOG2E;

constexpr size_t O_YP = 0, O_YS = O_YP + (size_t)MP * DM, O_AKP = O_YS + (size_t)MS * DM, O_AVP = O_AKP + 16 * 128 * 128, O_BKP = O_AVP + 16 * 128 * 128,
                 O_BVP = O_BKP + (size_t)16 * 512 * 512, O_CVP = O_BVP + (size_t)16 * 512 * 512, O_AKS = O_CVP + 16 * 2 * FF, O_AVS = O_AKS + 8 * 16 * 128,
                 O_BKS = O_AVS + 8 * 16 * 128, O_BVS = O_BKS + 8 * 16 * 512, O_CVS = O_BVS + 8 * 16 * 512, O_END = O_CVS + 8 * 2 * FF;

constexpr size_t MiB = 1u << 20;
constexpr size_t WS_CTL = 0, CTL_ZERO_BYTES = 1 * MiB;
constexpr size_t WS_CS = 1 * MiB;
constexpr size_t WS_WIN = 2 * MiB, WS_WOAB = 12 * MiB, WS_WOUT = 15 * MiB, WS_WUP = 18 * MiB, WS_WD = 30 * MiB;
constexpr size_t WS_UHALO = 36 * MiB, WS_FIXU = 42 * MiB, WS_FIXV = 48 * MiB;
constexpr size_t WS_S1 = 54 * MiB;
constexpr size_t WS_SQ = 56 * MiB + 512 * 1024;
constexpr size_t WS_RSTD0 = 56 * MiB + 768 * 1024, WS_RSTD1 = 57 * MiB + 256 * 1024;
constexpr size_t WS_SKV = 58 * MiB;
constexpr size_t WS_XN = 70 * MiB;
constexpr size_t WS_QKV = 207 * MiB;
constexpr size_t WS_G = 497 * MiB;
constexpr size_t WS_O = 771 * MiB;
constexpr size_t WS_END = 908 * MiB;
constexpr size_t WS_X1B = 600 * MiB;
static_assert(WS_X1B >= WS_QKV + (size_t)MROWS * GTP * 2 && WS_X1B + (size_t)MROWS * AP * 2 <= WS_O && WS_X1B >= WS_G, "x1 buffer");
static_assert(WS_SKV + (size_t)SB * SKVR * SKVP * 2 <= WS_XN && WS_S1 + (size_t)MS * NIN * 4 <= WS_SQ && WS_SQ + (size_t)MS * SQP * 2 <= WS_RSTD0 && WS_RSTD0 + (size_t)MROWS * 4 <= WS_RSTD1 && WS_RSTD1 + (size_t)MROWS * 4 <= WS_SKV, "ws map small");
static_assert(WS_XN + (size_t)MROWS * AP * 2 <= WS_QKV && WS_QKV + (size_t)MROWS * QKVP * 2 <= WS_G && WS_G + (size_t)MROWS * GP * 2 <= WS_O && WS_O + (size_t)MROWS * AP * 2 <= WS_END, "ws map");
static_assert(WS_WIN + (size_t)NIN * AP * 2 <= WS_WOAB && WS_WOAB + (size_t)DM * AP * 2 <= WS_WOUT && WS_WOUT + (size_t)DM * AP * 2 <= WS_WUP && WS_WUP + (size_t)NUP * AP * 2 <= WS_WD && WS_WD + (size_t)DM * FF * 2 <= WS_UHALO, "ws weights");
static_assert(WS_QKV + (size_t)MROWS * GTP * 2 <= WS_O && WS_WD + (size_t)DM * GTP * 2 <= WS_UHALO, "gated overlay");
constexpr int CW_TMO = 0, CW_BAR = 4096, CW_ROUND = 16384;

constexpr int RING_BYTES = 131072;
constexpr int XLDS_OFF = RING_BYTES;
constexpr int MISC_OFF = RING_BYTES + 8192;
constexpr int LDS_BYTES = 151552;

#define RLX_AGENT __ATOMIC_RELAXED, __HIP_MEMORY_SCOPE_AGENT
__device__ __forceinline__ unsigned cvt_pk_bf16(float lo, float hi) { unsigned r; asm volatile("v_cvt_pk_bf16_f32 %0, %1, %2" : "=v"(r) : "v"(lo), "v"(hi)); return r; }
__device__ __forceinline__ unsigned f2bf(float f) { unsigned u = __builtin_bit_cast(unsigned, f); return (u + 0x7fffu + ((u >> 16) & 1u)) >> 16; }
__device__ __forceinline__ unsigned pk2(float lo, float hi) { return f2bf(lo) | (f2bf(hi) << 16); }
__device__ __forceinline__ float bf_lo(unsigned w) { return __builtin_bit_cast(float, w << 16); }
__device__ __forceinline__ float bf_hi(unsigned w) { return __builtin_bit_cast(float, w & 0xffff0000u); }
__device__ __forceinline__ float wave_sum(float v) {
#pragma unroll
    for (int o = 1; o < 64; o <<= 1) v += __shfl_xor(v, o);
    return v;
}
__device__ __forceinline__ float wave_max(float v) {
#pragma unroll
    for (int o = 1; o < 64; o <<= 1) v = fmaxf(v, __shfl_xor(v, o));
    return v;
}
__device__ __forceinline__ f32x2 gelu_pk(f32x2 v) {
    const f32x2 av = __builtin_elementwise_abs(v), d = av * 0.2316418882f + 1.0f;
    f32x2 t; t.x = __builtin_amdgcn_rcpf(d.x); t.y = __builtin_amdgcn_rcpf(d.y);
    f32x2 q = t * 0.5307027145f + (-0.7265760135f); q = q * t + 0.7107068705f; q = q * t + (-0.142248368f); q = q * t + 0.127414796f; q = q * t;
    const f32x2 s = (v * v) * (-0.72134752044f);
    f32x2 e; e.x = __builtin_amdgcn_exp2f(s.x); e.y = __builtin_amdgcn_exp2f(s.y);
    const f32x2 m = v * (q * e), r = v - m;
    f32x2 o; o.x = v.x < 0.f ? m.x : r.x; o.y = v.y < 0.f ? m.y : r.y; return o;
}
__device__ __forceinline__ float gelu1(float v) { f32x2 r = gelu_pk((f32x2){v, v}); return r.x; }
__device__ __forceinline__ float sigmoidf_(float g) { g = fminf(fmaxf(g, -30.f), 30.f); return 1.0f / (1.0f + __expf(-g)); }

__host__ __device__ __forceinline__ int rope_j(int d) { return d < 32 ? 8 * (d >> 2) + (d & 3) : 8 * ((d - 32) >> 2) + 4 + ((d - 32) & 3); }
__host__ __device__ __forceinline__ int rope_d(int j) { const int q = j >> 3, e = j & 7; return e < 4 ? 4 * q + e : 32 + 4 * q + (e - 4); }
__host__ __device__ __forceinline__ int gcol_in(int n) {
    if (n < 640) return (n & ~63) + rope_j(n & 63);
    if (n < 2304) return n;
    if (n < 3328) { const int c = n - 2304; return 2304 + 256 * (c >> 7) + (c & 127); }
    const int c = n - 3328; return 2304 + 256 * (c >> 7) + 128 + (c & 127);
}
__host__ __device__ __forceinline__ int src_in(int g) {
    if (g < 640) return (g & ~63) + rope_d(g & 63);
    if (g < 2304) return g;
    const int c = g - 2304, p = c >> 8, w = c & 255; return w < 128 ? 2304 + 128 * p + w : 3328 + 128 * p + (w - 128);
}
__host__ __device__ __forceinline__ int gcol_up(int n) { if (n < FF) return 256 * (n >> 7) + (n & 127); const int c = n - FF; return 256 * (c >> 7) + 128 + (c & 127); }

namespace pg8 {
constexpr int BM = 256, BK = 64, HALF = 128, HTB = HALF * BK * 2, STAGE_BYTES = 8 * HTB, NXCD = 8, WGM = 8;
__host__ __device__ __forceinline__ int lds_byte(int r, int c) { const int st = (r >> 4) * 2 + (c >> 5), rr = r & 15, cc = c & 31, ob = rr * 64 + cc * 2; return st * 1024 + (ob ^ (((ob >> 9) & 1) << 5)); }
__host__ __device__ __forceinline__ void stage_rc(int b, int& R, int& C) { const int st = b / 1024, sb = b % 1024, swz = sb ^ (((sb >> 9) & 1) << 5); R = (st >> 1) * 16 + swz / 64; C = (st & 1) * 32 + (swz % 64) / 2; }
__host__ __device__ __forceinline__ int perm32(int rho) { const int n = rho >> 4, i = rho & 15; return 8 * (i >> 2) + 4 * n + (i & 3); }
struct Unit { int pm, pn; };
struct Gemm { const bf16_t* A; const bf16_t* Bt; int M, N, K, lda, ldb; const bf16_t* A2 = nullptr; };
struct StaticOrder {
    int nM, nN, nwg, G, c, rep, sub_n = 0, sub_o = 0;
    unsigned* rcnt = nullptr; unsigned nloc = 0;
    __host__ __device__ void init(int M, int N, int G_, int c_, int rep_ = 1) { nM = M / BM; nN = N / BM; nwg = nM * nN; G = G_; c = c_; rep = rep_; }
    __host__ __device__ bool next(int i, Unit& u) const {
        if (rep > 1) { const int rounds = (nwg + G - 1) / G; if (i >= rep * rounds) return false; i = i % rounds; }
        if (sub_n > 0) { const int rounds = (nwg + G - 1) / G;
            if (i >= rounds) { const int i2 = i - rounds, nw2 = nM * sub_n; const long L2 = (long)i2 * G + c; if (L2 >= nw2) return false;
                int w2 = (int)L2; { const int q = nw2 / NXCD, xcd = w2 % NXCD, off = w2 / NXCD; w2 = xcd * q + off; }
                const int nig2 = WGM * sub_n; u.pm = (w2 / nig2) * WGM + ((w2 % nig2) % WGM); u.pn = sub_o + (w2 % nig2) / WGM; return true; } }
        const long L = (long)i * G + c; if (L >= nwg) return false;
        int wgid = (int)L; { const int q = nwg / NXCD, r = nwg % NXCD, xcd = wgid % NXCD, off = wgid / NXCD; wgid = (xcd < r ? xcd * (q + 1) : r * (q + 1) + (xcd - r) * q) + off; }
        const int nig = WGM * nN, gid = wgid / nig, fm = gid * WGM, gsz = (nM - fm) < WGM ? (nM - fm) : WGM;
        u.pm = fm + ((wgid % nig) % gsz); u.pn = (wgid % nig) / gsz; return true;
    }
};

typedef f32x4 Acc[2][2][4][2];

struct EpiBf16 {
    static constexpr bool HAS_MID = false; static constexpr int MID_T = 0;
    bf16_t* O; int ldc;
    __device__ __forceinline__ void mid(Acc&, const Unit&, int, int, int, int) const {}
    __device__ __forceinline__ void operator()(Acc& acc, const Unit& u, int wr, int wc, int fr, int fq, LAS unsigned char*) const {
        asm volatile("" : "+v"(fr), "+v"(fq));
        const int row0 = u.pm * BM + wr * 64 + fr, col0 = u.pn * BM + wc * 32 + 8 * fq;
#pragma unroll
        for (int ai = 0; ai < 2; ++ai)
#pragma unroll
            for (int m = 0; m < 4; ++m) { bf16_t* rowp = O + (size_t)(row0 + ai * HALF + m * 16) * ldc + col0;
#pragma unroll
                for (int bj = 0; bj < 2; ++bj) { const f32x4 v0 = acc[ai][bj][m][0], v1 = acc[ai][bj][m][1];
                    u32x4 w; w.x = cvt_pk_bf16(v0[0], v0[1]); w.y = cvt_pk_bf16(v0[2], v0[3]); w.z = cvt_pk_bf16(v1[0], v1[1]); w.w = cvt_pk_bf16(v1[2], v1[3]);
                    *(u32x4*)(rowp + bj * HALF) = w; } }
    }
};

struct EpiIn {
    static constexpr bool HAS_MID = false; static constexpr int MID_T = 0;
    bf16_t* QKV; bf16_t* G; const float* CS; float* out; const float* rstd;
    __device__ __forceinline__ void mid(Acc&, const Unit&, int, int, int, int) const {}
    __device__ __forceinline__ void operator()(Acc& acc, const Unit& u, int wr, int wc, int fr, int fq, LAS unsigned char*) const {
        asm volatile("" : "+v"(fr), "+v"(fq));
        { float rs[2][4];
#pragma unroll
          for (int ai = 0; ai < 2; ++ai)
#pragma unroll
              for (int m = 0; m < 4; ++m) rs[ai][m] = rstd[u.pm * BM + ai * HALF + wr * 64 + m * 16 + fr];
#pragma unroll
          for (int ai = 0; ai < 2; ++ai)
#pragma unroll
              for (int bj = 0; bj < 2; ++bj)
#pragma unroll
                  for (int m = 0; m < 4; ++m) { acc[ai][bj][m][0] *= rs[ai][m]; acc[ai][bj][m][1] *= rs[ai][m]; } }
        const int pn = u.pn, pm = u.pm;
        const int row0 = pm * BM + wr * 64 + fr, cl = wc * 32 + 8 * fq;
        const int bb = pm >> 4, tail = pm & 15;
        if (pn <= 2) {
            const float sc = (pn < 2) ? C2 : 1.0f;
            const int dd0 = 16 * (wc & 1) + 4 * fq, g = wc >> 1;
            f32x4 csv[2][4], snv[2][4];
#pragma unroll
            for (int ai = 0; ai < 2; ++ai)
#pragma unroll
                for (int m = 0; m < 4; ++m) { const int t = (row0 + ai * HALF + m * 16) & (SEQ - 1); csv[ai][m] = *(const f32x4*)(CS + (size_t)t * 64 + dd0); snv[ai][m] = *(const f32x4*)(CS + (size_t)t * 64 + 32 + dd0); }
            __builtin_amdgcn_sched_barrier(0);
#pragma unroll
            for (int ai = 0; ai < 2; ++ai)
#pragma unroll
                for (int m = 0; m < 4; ++m) {
                    const int row = row0 + ai * HALF + m * 16, t = row & (SEQ - 1);
                    const f32x4 cs = csv[ai][m], sn = snv[ai][m];
#pragma unroll
                    for (int bj = 0; bj < 2; ++bj) {
                        const f32x4 x1 = acc[ai][bj][m][0], x2 = acc[ai][bj][m][1];
                        bf16_t* dst = (pn < 2) ? QKV + H_QA + hm_off(8, bb, 4 * pn + 2 * bj + g, t) + 32 * (wc & 1) + 8 * fq
                                               : QKV + (bj == 0 ? H_KA : H_VA) + hm_off(2, bb, g, t) + 32 * (wc & 1) + 8 * fq;
                        if (pn == 2 && bj == 1) {
                            u32x4 w; w.x = cvt_pk_bf16(x1[0], x1[1]); w.y = cvt_pk_bf16(x1[2], x1[3]); w.z = cvt_pk_bf16(x2[0], x2[1]); w.w = cvt_pk_bf16(x2[2], x2[3]);
                            *(u32x4*)dst = w;
                            if (tail == 15 && ai == 1) { float* o = out + O_AVP + ((size_t)(bb * 128 + (t - (SEQ - 128))) * 2 + g) * 64 + 32 * (wc & 1) + 8 * fq; *(f32x4*)o = x1; *(f32x4*)(o + 4) = x2; }
                        } else {
                            const f32x4 o1 = (x1 * cs - x2 * sn) * sc, o2 = (x2 * cs + x1 * sn) * sc;
                            u32x4 w; w.x = cvt_pk_bf16(o1[0], o1[1]); w.y = cvt_pk_bf16(o1[2], o1[3]); w.z = cvt_pk_bf16(o2[0], o2[1]); w.w = cvt_pk_bf16(o2[2], o2[3]);
                            *(u32x4*)dst = w;
                            if (pn == 2 && tail == 15 && ai == 1) { float* o = out + O_AKP + ((size_t)(bb * 128 + (t - (SEQ - 128))) * 2 + g) * 64 + dd0; *(f32x4*)o = o1; *(f32x4*)(o + 32) = o2; }
                        }
                    }
                }
        } else if (pn <= 8) {
            const float sc = (pn <= 4) ? C2 : 1.0f;
            float* cout = nullptr; int ccol = 0;
            if (pn >= 5 && tail >= 14) { cout = out + ((pn <= 6) ? O_BKP : O_BVP); ccol = ((pn - 5) & 1) * BM + cl; }
#pragma unroll
            for (int ai = 0; ai < 2; ++ai)
#pragma unroll
                for (int m = 0; m < 4; ++m) {
                    const int row = row0 + ai * HALF + m * 16, t = row & (SEQ - 1);
#pragma unroll
                    for (int bj = 0; bj < 2; ++bj) {
                        const f32x4 v0 = acc[ai][bj][m][0] * sc, v1 = acc[ai][bj][m][1] * sc;
                        u32x4 w; w.x = cvt_pk_bf16(v0[0], v0[1]); w.y = cvt_pk_bf16(v0[2], v0[3]); w.z = cvt_pk_bf16(v1[0], v1[1]); w.w = cvt_pk_bf16(v1[2], v1[3]);
                        { const size_t tb = (pn <= 4) ? H_QB : ((pn <= 6) ? H_KB : H_VB); const int hd = 4 * ((pn - 3) & 1) + 2 * bj + (wc >> 1);
                          *(u32x4*)(QKV + tb + hm_off(8, bb, hd, t) + 32 * (wc & 1) + 8 * fq) = w; }
                        if (cout) { float* o = cout + ((size_t)(bb * 512 + (t - (SEQ - 512)))) * 512 + ccol + bj * HALF; *(f32x4*)o = v0; *(f32x4*)(o + 4) = v1; }
                    }
                }
        } else {
            const int c0 = 128 * (pn - 9) + cl;
#pragma unroll
            for (int ai = 0; ai < 2; ++ai)
#pragma unroll
                for (int m = 0; m < 4; ++m) {
                    const int row = row0 + ai * HALF + m * 16;
                    float rt[8], sg[8];
#pragma unroll
                    for (int n = 0; n < 2; ++n)
#pragma unroll
                        for (int i = 0; i < 4; ++i) {
                            const float ga = fminf(fmaxf(acc[ai][0][m][n][i], -30.f), 30.f), gb = fminf(fmaxf(acc[ai][1][m][n][i], -30.f), 30.f);
                            const float ea = __expf(-ga), eb = __expf(-gb);
                            sg[4 * n + i] = __builtin_amdgcn_rcpf(1.0f + eb); rt[4 * n + i] = (1.0f + eb) * __builtin_amdgcn_rcpf(1.0f + ea);
                        }
                    u32x4 w; w.x = cvt_pk_bf16(rt[0], rt[1]); w.y = cvt_pk_bf16(rt[2], rt[3]); w.z = cvt_pk_bf16(rt[4], rt[5]); w.w = cvt_pk_bf16(rt[6], rt[7]);
                    *(u32x4*)(G + (size_t)row * GP + c0) = w;
                    w.x = cvt_pk_bf16(sg[0], sg[1]); w.y = cvt_pk_bf16(sg[2], sg[3]); w.z = cvt_pk_bf16(sg[4], sg[5]); w.w = cvt_pk_bf16(sg[6], sg[7]);
                    *(u32x4*)(G + (size_t)row * GP + 1024 + c0) = w;
                }
        }
    }
};

struct EpiGate {
    static constexpr bool HAS_MID = true; static constexpr int MID_T = 8;
    const bf16_t* G; bf16_t* O;
    __device__ __forceinline__ void mid(Acc& acc, const Unit& u, int wr, int wc, int fr, int fq) const {
        asm volatile("" : "+v"(fr), "+v"(fq));
        const int row0 = u.pm * BM + wr * 64 + fr, col0 = u.pn * BM + wc * 32 + 8 * fq;
        u32x4 g[2][4][2];
#pragma unroll
        for (int ai = 0; ai < 2; ++ai)
#pragma unroll
            for (int m = 0; m < 4; ++m)
#pragma unroll
                for (int bj = 0; bj < 2; ++bj) g[ai][m][bj] = *(const u32x4*)(G + (size_t)(row0 + ai * HALF + m * 16) * GP + col0 + bj * HALF);
        __builtin_amdgcn_sched_barrier(0);
#pragma unroll
        for (int ai = 0; ai < 2; ++ai)
#pragma unroll
            for (int m = 0; m < 4; ++m)
#pragma unroll
                for (int bj = 0; bj < 2; ++bj) { const u32x4 w = g[ai][m][bj];
                    acc[ai][bj][m][0] *= (f32x4){bf_lo(w.x), bf_hi(w.x), bf_lo(w.y), bf_hi(w.y)}; acc[ai][bj][m][1] *= (f32x4){bf_lo(w.z), bf_hi(w.z), bf_lo(w.w), bf_hi(w.w)}; }
    }
    __device__ __forceinline__ void operator()(Acc& acc, const Unit& u, int wr, int wc, int fr, int fq, LAS unsigned char*) const {
        asm volatile("" : "+v"(fr), "+v"(fq));
        const int row0 = u.pm * BM + wr * 64 + fr, col0 = u.pn * BM + wc * 32 + 8 * fq;
        u32x4 g[2][4][2];
#pragma unroll
        for (int ai = 0; ai < 2; ++ai)
#pragma unroll
            for (int m = 0; m < 4; ++m)
#pragma unroll
                for (int bj = 0; bj < 2; ++bj) g[ai][m][bj] = *(const u32x4*)(G + (size_t)(row0 + ai * HALF + m * 16) * GP + 1024 + col0 + bj * HALF);
        __builtin_amdgcn_sched_barrier(0);
#pragma unroll
        for (int ai = 0; ai < 2; ++ai)
#pragma unroll
            for (int m = 0; m < 4; ++m) { const size_t row = (size_t)(row0 + ai * HALF + m * 16);
#pragma unroll
                for (int bj = 0; bj < 2; ++bj) { const u32x4 gg = g[ai][m][bj];
                    const f32x4 v0 = acc[ai][bj][m][0] * (f32x4){bf_lo(gg.x), bf_hi(gg.x), bf_lo(gg.y), bf_hi(gg.y)}, v1 = acc[ai][bj][m][1] * (f32x4){bf_lo(gg.z), bf_hi(gg.z), bf_lo(gg.w), bf_hi(gg.w)};
                    u32x4 w; w.x = cvt_pk_bf16(v0[0], v0[1]); w.y = cvt_pk_bf16(v0[2], v0[3]); w.z = cvt_pk_bf16(v1[0], v1[1]); w.w = cvt_pk_bf16(v1[2], v1[3]);
                    *(u32x4*)(O + row * AP + col0 + bj * HALF) = w; } }
    }
};

__device__ __forceinline__ float dpp_ror1(float v) { return __builtin_bit_cast(float, __builtin_amdgcn_update_dpp(0, __builtin_bit_cast(int, v), 0x121, 0xf, 0xf, true)); }
__device__ __forceinline__ float dpp_ror2(float v) { return __builtin_bit_cast(float, __builtin_amdgcn_update_dpp(0, __builtin_bit_cast(int, v), 0x122, 0xf, 0xf, true)); }

struct EpiUp {
    static constexpr bool HAS_MID = false; static constexpr int MID_T = 0;
    bf16_t* GT; const float* cw; const float* cb; float* uhalo; float* fixu; float* fixv; float* out; const float* rstd;
    __device__ __forceinline__ void mid(Acc&, const Unit&, int, int, int, int) const {}
    __device__ __forceinline__ void operator()(Acc& acc, const Unit& u, int wr, int wc, int fr, int fq, LAS unsigned char* xl) const {
        asm volatile("" : "+v"(fr), "+v"(fq));
        f32x4 cwa[2], cwb[2], cwc[2], cwd[2];
        { const int c0_ = u.pn * HALF + wc * 32 + 8 * fq;
#pragma unroll
          for (int n = 0; n < 2; ++n) { cwa[n] = *(const f32x4*)(cw + c0_ + 4 * n); cwb[n] = *(const f32x4*)(cw + FF + c0_ + 4 * n); cwc[n] = *(const f32x4*)(cw + 2 * FF + c0_ + 4 * n); cwd[n] = *(const f32x4*)(cb + c0_ + 4 * n); } }
        { float rs[2][4];
#pragma unroll
          for (int ai = 0; ai < 2; ++ai)
#pragma unroll
              for (int m = 0; m < 4; ++m) rs[ai][m] = rstd[u.pm * BM + ai * HALF + wr * 64 + m * 16 + fr];
          __builtin_amdgcn_sched_barrier(0);
#pragma unroll
          for (int ai = 0; ai < 2; ++ai)
#pragma unroll
              for (int bj = 0; bj < 2; ++bj)
#pragma unroll
                  for (int m = 0; m < 4; ++m) { acc[ai][bj][m][0] *= rs[ai][m]; acc[ai][bj][m][1] *= rs[ai][m]; } }
        const int pm = u.pm, pn = u.pn, cl = wc * 32 + 8 * fq, col0 = pn * HALF + cl;
        LAS float* X = (LAS float*)xl;
        if (fr >= 14) {
#pragma unroll
            for (int ai = 0; ai < 2; ++ai)
#pragma unroll
                for (int n = 0; n < 2; ++n) *(LAS f32x4*)(X + ((ai * 2 + wr) * 2 + (fr - 14)) * 128 + cl + 4 * n) = acc[ai][0][3][n];
            if (wr == 1) {
                float* h = uhalo + ((size_t)pm * 2 + (fr - 14)) * FF + col0; *(f32x4*)h = acc[1][0][3][0]; *(f32x4*)(h + 4) = acc[1][0][3][1];
                if ((pm & 15) == 15) { float* o = out + O_CVP + ((size_t)(pm >> 4) * 2 + (fr - 14)) * FF + col0; *(f32x4*)o = acc[1][0][3][0]; *(f32x4*)(o + 4) = acc[1][0][3][1]; }
            }
        }
        if (wr == 0 && fr < 2) {
            float* a = fixu + ((size_t)pm * 2 + fr) * FF + col0; *(f32x4*)a = acc[0][0][0][0]; *(f32x4*)(a + 4) = acc[0][0][0][1];
            float* b = fixv + ((size_t)pm * 2 + fr) * FF + col0; *(f32x4*)b = acc[0][1][0][0]; *(f32x4*)(b + 4) = acc[0][1][0][1];
        }
        asm volatile("s_waitcnt lgkmcnt(0)" ::: "memory"); __builtin_amdgcn_s_barrier(); asm volatile("" ::: "memory");
        float w0[8], w1[8], w2[8], bz[8];
#pragma unroll
        for (int n = 0; n < 2; ++n) { const f32x4 a = cwa[n], b = cwb[n], c = cwc[n], d = cwd[n];
#pragma unroll
            for (int i = 0; i < 4; ++i) { w0[4 * n + i] = a[i]; w1[4 * n + i] = b[i]; w2[4 * n + i] = c[i]; bz[4 * n + i] = d[i]; } }
#pragma unroll
        for (int ai = 0; ai < 2; ++ai) {
            f32x4 h14[2], h15[2];
            const int src = (wr == 1) ? (ai * 2 + 0) : (0 * 2 + 1);
            const bool has = (wr == 1) || (ai == 1);
#pragma unroll
            for (int n = 0; n < 2; ++n) {
                h14[n] = has ? *(const LAS f32x4*)(X + (src * 2 + 0) * 128 + cl + 4 * n) : (f32x4){0.f, 0.f, 0.f, 0.f};
                h15[n] = has ? *(const LAS f32x4*)(X + (src * 2 + 1) * 128 + cl + 4 * n) : (f32x4){0.f, 0.f, 0.f, 0.f};
            }
#pragma unroll
            for (int m = 0; m < 4; ++m) {
                float gt[8];
#pragma unroll
                for (int n = 0; n < 2; ++n)
#pragma unroll
                    for (int i = 0; i < 4; ++i) {
                        const float cur = acc[ai][0][m][n][i];
                        float p1 = dpp_ror1(cur), p2 = dpp_ror2(cur);
                        if (m > 0) { const float pv = acc[ai][0][m > 0 ? m - 1 : 0][n][i]; const float q1 = dpp_ror1(pv), q2 = dpp_ror2(pv); p1 = (fr == 0) ? q1 : p1; p2 = (fr < 2) ? q2 : p2; }
                        else { p1 = (fr == 0) ? h15[n][i] : p1; p2 = (fr == 0) ? h14[n][i] : ((fr == 1) ? h15[n][i] : p2); }
                        const float cv = bz[4 * n + i] + w0[4 * n + i] * p2 + w1[4 * n + i] * p1 + w2[4 * n + i] * cur;
                        gt[4 * n + i] = cv;
                    }
#pragma unroll
                for (int k = 0; k < 8; k += 2) { const f32x2 r = gelu_pk((f32x2){gt[k], gt[k + 1]}); gt[k] = r.x * acc[ai][1][m][k >> 2][k & 3]; gt[k + 1] = r.y * acc[ai][1][m][(k + 1) >> 2][(k + 1) & 3]; }
                u32x4 w; w.x = cvt_pk_bf16(gt[0], gt[1]); w.y = cvt_pk_bf16(gt[2], gt[3]); w.z = cvt_pk_bf16(gt[4], gt[5]); w.w = cvt_pk_bf16(gt[6], gt[7]);
                *(u32x4*)(GT + (size_t)(pm * BM + ai * HALF + wr * 64 + m * 16 + fr) * GTP + col0) = w;
            }
        }
    }
};

template <class Epi, class Sched>
__device__ __forceinline__ void gemm_phase(LAS unsigned char* lds, LAS unsigned char* xlds, const Gemm g, const Sched& S, const Epi& E) {
    const int tid = threadIdx.x, wid = __builtin_amdgcn_readfirstlane(tid >> 6), lane = tid & 63, wr = wid >> 2, wc = wid & 3, fr = lane & 15, fq = lane >> 4;
    const int K = g.K, nt = K / BK;
    unsigned voffA[2], voffB[2];
#pragma unroll
    for (int i = 0; i < 2; ++i) { int R, C; stage_rc(tid * 16 + i * 8192, R, C); const int Rb = (R & ~31) + perm32(R & 31);
        voffA[i] = (unsigned)(R * g.lda + C) * 2u; voffB[i] = (unsigned)(Rb * g.ldb + C) * 2u; }
    const size_t kstep = (size_t)(BK * 2);
    const size_t hstepA = (size_t)HALF * g.lda * 2, hstepB = (size_t)HALF * g.ldb * 2;
    const size_t tstepA = 2 * hstepA, tstepB = 2 * hstepB;
    const unsigned ldsw = (unsigned)wid * 1024u;
    const int aoff = lds_byte(wr * 64 + fr, fq * 8), boff = lds_byte(wc * 32 + fr, fq * 8);
#define PG8_SA(b, h) (((b) * 2 + (h)) * HTB)
#define PG8_SB(b, h) ((4 + (b) * 2 + (h)) * HTB)
#define PG8_STAGE(bufoff, gbase, voff) do { _Pragma("unroll") for (int _i = 0; _i < 2; ++_i) \
        __builtin_amdgcn_global_load_lds((const unsigned*)((const char*)(gbase) + (voff)[_i]), (LAS unsigned*)(lds + (bufoff) + ldsw + _i * 8192), 16, 0, 0); } while (0)
#define PG8_LDA(dst, b, h) do { _Pragma("unroll") for (int m = 0; m < 4; ++m) _Pragma("unroll") for (int k = 0; k < 2; ++k) dst[m][k] = *(const LAS bf16x8*)(lds + PG8_SA(b, h) + aoff + m * 2048 + k * 1024); } while (0)
#define PG8_LDB(dst, b, h) do { _Pragma("unroll") for (int n = 0; n < 2; ++n) _Pragma("unroll") for (int k = 0; k < 2; ++k) dst[n][k] = *(const LAS bf16x8*)(lds + PG8_SB(b, h) + boff + n * 2048 + k * 1024); } while (0)
#define PG8_MMA(ai, bj, At, Bt) do { __builtin_amdgcn_s_setprio(1); _Pragma("unroll") for (int m = 0; m < 4; ++m) _Pragma("unroll") for (int n = 0; n < 2; ++n) _Pragma("unroll") for (int k = 0; k < 2; ++k) \
        acc[ai][bj][m][n] = __builtin_amdgcn_mfma_f32_16x16x32_bf16(Bt[n][k], At[m][k], acc[ai][bj][m][n], 0, 0, 0); __builtin_amdgcn_s_setprio(0); } while (0)
#define PG8_WAIT_V(n) asm volatile("s_waitcnt vmcnt(" #n ")" ::: "memory")
#define PG8_WAIT_L(n) asm volatile("s_waitcnt lgkmcnt(" #n ")" ::: "memory")
#define PG8_BAR __builtin_amdgcn_s_barrier()
#define PG8_SCHED __builtin_amdgcn_sched_barrier(0)
    Unit cur, nxt; int ui = 0;
    if (!S.next(0, cur)) return;
    Acc acc;
#pragma unroll
    for (int a = 0; a < 2; ++a)
#pragma unroll
        for (int b = 0; b < 2; ++b)
#pragma unroll
            for (int m = 0; m < 4; ++m)
#pragma unroll
                for (int n = 0; n < 2; ++n) acc[a][b][m][n] = (f32x4){0.f, 0.f, 0.f, 0.f};
    bf16x8 At[4][2], B0[2][2], B1[2][2];
    const char* cA = (const char*)g.A + (size_t)cur.pm * tstepA; const char* cB = (const char*)g.Bt + (size_t)cur.pn * tstepB;
    PG8_STAGE(PG8_SB(0, 0), cB, voffB); PG8_STAGE(PG8_SB(0, 1), cB + hstepB, voffB); PG8_STAGE(PG8_SA(0, 0), cA, voffA); PG8_STAGE(PG8_SA(0, 1), cA + hstepA, voffA);
    if (wr == 1) PG8_BAR;
    PG8_WAIT_V(2); PG8_BAR;
    PG8_STAGE(PG8_SB(1, 0), cB + kstep, voffB); PG8_STAGE(PG8_SA(1, 0), cA + kstep, voffA); PG8_STAGE(PG8_SB(1, 1), cB + hstepB + kstep, voffB);
    PG8_WAIT_V(6); PG8_BAR;
    for (;;) {
        const bool has_next = S.next(ui + 1, nxt);
        const char* nA = has_next ? (const char*)((g.A2 && S.sub_n > 0 && ui + 1 >= (S.nwg + S.G - 1) / S.G) ? g.A2 : g.A) + (size_t)nxt.pm * tstepA : cA; const char* nB = has_next ? (const char*)g.Bt + (size_t)nxt.pn * tstepB : cB;
        for (int t = 0; t < nt; t += 2) {
            const bool last = (t == nt - 2);
            const char* a1 = cA + (size_t)(t + 1) * kstep;
            const char* a2 = last ? nA : cA + (size_t)(t + 2) * kstep; const char* b2 = last ? nB : cB + (size_t)(t + 2) * kstep;
            const char* a3 = a2 + kstep; const char* b3 = b2 + kstep;
            if constexpr (Epi::HAS_MID) { if (t == Epi::MID_T) { E.mid(acc, cur, wr, wc, fr, fq); PG8_SCHED; } }
            PG8_LDB(B0, 0, 0); PG8_LDB(B1, 0, 1); PG8_SCHED; PG8_LDA(At, 0, 0); PG8_STAGE(PG8_SA(1, 1), a1 + hstepA, voffA);
            PG8_WAIT_V(8); PG8_WAIT_L(0); PG8_BAR; PG8_MMA(0, 0, At, B0); PG8_MMA(0, 1, At, B1); PG8_BAR; PG8_SCHED;
            PG8_LDA(At, 0, 1); PG8_STAGE(PG8_SB(0, 0), b2, voffB); PG8_STAGE(PG8_SB(0, 1), b2 + hstepB, voffB); PG8_STAGE(PG8_SA(0, 0), a2, voffA);
            PG8_WAIT_V(8); PG8_WAIT_L(0); PG8_BAR; PG8_MMA(1, 0, At, B0); PG8_MMA(1, 1, At, B1); PG8_BAR; PG8_SCHED;
            PG8_LDB(B0, 1, 0); PG8_LDB(B1, 1, 1); PG8_SCHED; PG8_LDA(At, 1, 0); PG8_STAGE(PG8_SA(0, 1), a2 + hstepA, voffA);
            PG8_WAIT_V(8); PG8_WAIT_L(0); PG8_BAR; PG8_MMA(0, 0, At, B0); PG8_MMA(0, 1, At, B1); PG8_BAR; PG8_SCHED;
            PG8_LDA(At, 1, 1); PG8_STAGE(PG8_SB(1, 0), b3, voffB); PG8_STAGE(PG8_SB(1, 1), b3 + hstepB, voffB); PG8_STAGE(PG8_SA(1, 0), a3, voffA);
            PG8_WAIT_V(8); PG8_WAIT_L(0); PG8_BAR; PG8_MMA(1, 0, At, B0); PG8_MMA(1, 1, At, B1); PG8_BAR; PG8_SCHED;
        }
        if (wr == 0) PG8_BAR;
        if (!(PROBE_NOEPI && S.sub_n > 0 && ui >= (S.nwg + S.G - 1) / S.G)) E(acc, cur, wr, wc, fr, fq, xlds);
        if (!has_next) break;
        if (ROUND_SYNC && S.rcnt) {
            if (tid == 0) { const unsigned old = __hip_atomic_fetch_add(S.rcnt, 1u, __ATOMIC_RELAXED, __HIP_MEMORY_SCOPE_AGENT); const unsigned target = (old / S.nloc + 1u) * S.nloc; unsigned sp = 0;
                while (__hip_atomic_load(S.rcnt, __ATOMIC_RELAXED, __HIP_MEMORY_SCOPE_AGENT) < target) { __builtin_amdgcn_s_sleep(1); if (++sp > (1u << 16)) break; } }
            PG8_BAR;
        }
#pragma unroll
        for (int a = 0; a < 2; ++a)
#pragma unroll
            for (int b = 0; b < 2; ++b)
#pragma unroll
                for (int m = 0; m < 4; ++m)
#pragma unroll
                    for (int n = 0; n < 2; ++n) acc[a][b][m][n] = (f32x4){0.f, 0.f, 0.f, 0.f};
        cur = nxt; cA = nA; cB = nB; ++ui;
        if (wr == 1) PG8_BAR;
    }
    PG8_WAIT_V(0);
    PG8_BAR;
#undef PG8_SA
#undef PG8_SB
#undef PG8_STAGE
#undef PG8_LDA
#undef PG8_LDB
#undef PG8_MMA
#undef PG8_WAIT_V
#undef PG8_WAIT_L
#undef PG8_BAR
#undef PG8_SCHED
}
}

namespace att {
constexpr int SLOTB = 8192, NSLOT = 8;
constexpr int L_K = 0, L_V = NSLOT * SLOTB, L_WS = RING_BYTES, L_SINK = L_WS + 8 * 256, L_BIAS = L_SINK + 64, L_END = L_BIAS + 2 * 260 * 4;
constexpr int L_OST = MISC_OFF + 1024;
static_assert(2 * NSLOT * SLOTB <= RING_BYTES && L_END <= MISC_OFF && L_OST + 8 * 1024 <= LDS_BYTES, "attention LDS");
constexpr float THR = 8.0f;
typedef LAS const char* lds_cptr;
__device__ __forceinline__ int crow(int r, int hi) { return (r & 3) + 8 * (r >> 2) + 4 * hi; }
__device__ __forceinline__ void glds16(const void* gsrc, unsigned lds_dst) { unsigned keep;
    asm volatile("s_mov_b32 %0, m0\n\ts_mov_b32 m0, %2\n\ts_nop 0\n\tglobal_load_lds_dwordx4 %1, off\n\ts_mov_b32 m0, %0" : "=&s"(keep) : "v"(gsrc), "s"(lds_dst) : "memory"); }
#define ATT_WAIT_BAR(N) asm volatile("s_waitcnt vmcnt(" #N ") lgkmcnt(0)\n\ts_barrier" ::: "memory")
__device__ __forceinline__ float rowmax32(const f32x16& p0, const f32x16& p1) {
    float a = fmaxf(fmaxf(p0[0], p0[1]), p1[0]), b = fmaxf(fmaxf(p0[2], p0[3]), p1[1]); a = fmaxf(fmaxf(a, p1[2]), p1[3]);
#pragma unroll
    for (int r = 4; r < 16; r += 4) { a = fmaxf(fmaxf(a, p0[r]), p0[r + 1]); b = fmaxf(fmaxf(b, p0[r + 2]), p0[r + 3]); a = fmaxf(fmaxf(a, p1[r]), p1[r + 1]); b = fmaxf(fmaxf(b, p1[r + 2]), p1[r + 3]); }
    const float m = fmaxf(a, b);
    auto rr = __builtin_amdgcn_permlane32_swap(__float_as_uint(m), __float_as_uint(m), false, false);
    return fmaxf(__uint_as_float(rr[0]), __uint_as_float(rr[1]));
}
__device__ __forceinline__ void pv(f32x16* o, int vb, bf16x8 pa0, bf16x8 pa1, bf16x8 pa2, bf16x8 pa3) {
#pragma unroll
    for (int d0 = 0; d0 < 2; ++d0) { s16x4 lo[4], hi[4];
#pragma unroll
        for (int ks = 0; ks < 4; ++ks) {
            asm volatile("ds_read_b64_tr_b16 %0,%1 offset:%c2" : "=&v"(lo[ks]) : "v"(vb), "i"(d0 * 4096 + ks * 1024) : "memory");
            asm volatile("ds_read_b64_tr_b16 %0,%1 offset:%c2" : "=&v"(hi[ks]) : "v"(vb), "i"(d0 * 4096 + ks * 1024 + 512) : "memory"); }
        asm volatile("s_waitcnt lgkmcnt(0)" ::: "memory"); __builtin_amdgcn_sched_barrier(0);
#define ATT_PK(k) (bf16x8){lo[k][0], lo[k][1], lo[k][2], lo[k][3], hi[k][0], hi[k][1], hi[k][2], hi[k][3]}
        o[d0] = __builtin_amdgcn_mfma_f32_32x32x16_bf16(pa0, ATT_PK(0), o[d0], 0, 0, 0);
        o[d0] = __builtin_amdgcn_mfma_f32_32x32x16_bf16(pa1, ATT_PK(1), o[d0], 0, 0, 0);
        o[d0] = __builtin_amdgcn_mfma_f32_32x32x16_bf16(pa2, ATT_PK(2), o[d0], 0, 0, 0);
        o[d0] = __builtin_amdgcn_mfma_f32_32x32x16_bf16(pa3, ATT_PK(3), o[d0], 0, 0, 0);
#undef ATT_PK
    }
}
typedef short v4i16_t __attribute__((ext_vector_type(4)));
struct VFrag { s16x4 lo[8], hi[8]; };
__device__ __forceinline__ void vload(VFrag& f, lds_cptr vp) {
#pragma unroll
    for (int d0 = 0; d0 < 2; ++d0)
#pragma unroll
        for (int ks = 0; ks < 4; ++ks) {
            f.lo[d0 * 4 + ks] = __builtin_bit_cast(s16x4, __builtin_amdgcn_ds_read_tr16_b64_v4i16((LAS v4i16_t*)(vp + d0 * 4096 + ks * 1024)));
            f.hi[d0 * 4 + ks] = __builtin_bit_cast(s16x4, __builtin_amdgcn_ds_read_tr16_b64_v4i16((LAS v4i16_t*)(vp + d0 * 4096 + ks * 1024 + 512))); }
}
__device__ __forceinline__ void pv2(f32x16* o, const VFrag& f, bf16x8 pa0, bf16x8 pa1, bf16x8 pa2, bf16x8 pa3) {
#define ATT_VF(i) (bf16x8){f.lo[i][0], f.lo[i][1], f.lo[i][2], f.lo[i][3], f.hi[i][0], f.hi[i][1], f.hi[i][2], f.hi[i][3]}
    o[0] = __builtin_amdgcn_mfma_f32_32x32x16_bf16(pa0, ATT_VF(0), o[0], 0, 0, 0); o[1] = __builtin_amdgcn_mfma_f32_32x32x16_bf16(pa0, ATT_VF(4), o[1], 0, 0, 0);
    o[0] = __builtin_amdgcn_mfma_f32_32x32x16_bf16(pa1, ATT_VF(1), o[0], 0, 0, 0); o[1] = __builtin_amdgcn_mfma_f32_32x32x16_bf16(pa1, ATT_VF(5), o[1], 0, 0, 0);
    o[0] = __builtin_amdgcn_mfma_f32_32x32x16_bf16(pa2, ATT_VF(2), o[0], 0, 0, 0); o[1] = __builtin_amdgcn_mfma_f32_32x32x16_bf16(pa2, ATT_VF(6), o[1], 0, 0, 0);
    o[0] = __builtin_amdgcn_mfma_f32_32x32x16_bf16(pa3, ATT_VF(3), o[0], 0, 0, 0); o[1] = __builtin_amdgcn_mfma_f32_32x32x16_bf16(pa3, ATT_VF(7), o[1], 0, 0, 0);
#undef ATT_VF
}
struct AU { const bf16_t* Qw; const bf16_t* Kt0; const bf16_t* Vt0; bf16_t* Ow; int j0, NT, wlo, whi; float sink2; int bias_off, jrel0, qq0; };
template <int MODE, bool SMP>
__device__ __forceinline__ void attn_unit(char* shm, const AU u, const int kpitch, const int qpitch, const bool pre, const bool has_next, const AU nx, bf16x8 (&qr)[4]) {
    const bf16_t* Qw = u.Qw; const bf16_t* Kt0 = u.Kt0; const bf16_t* Vt0 = u.Vt0; bf16_t* Ow = u.Ow;
    const int j0 = u.j0, NT = u.NT, wlo = u.wlo, whi = u.whi, bias_off = u.bias_off, jrel0 = u.jrel0, qq0 = u.qq0; const float sink2 = u.sink2;
    const int tid = threadIdx.x, lane = tid & 63, r32 = lane & 31, hi = lane >> 5; const int wid = __builtin_amdgcn_readfirstlane(tid >> 6);
    const unsigned lds0 = (unsigned)(uintptr_t)shm;
    LAS float* wsf = (LAS float*)((LAS char*)shm + L_WS) + wid * 64;
    const long koffl = (long)lane * kpitch + wid * 8, voffl = (long)(16 * (wid & 3) + (lane >> 2)) * kpitch + (wid >> 2) * 32 + (lane & 3) * 8;
    const bf16_t* ksrc = Kt0 + koffl;
    const bf16_t* vsrc = Vt0 + voffl;
    const unsigned kdst = lds0 + L_K + wid * 1024, vdst = lds0 + L_V + wid * 1024;
#define ATT_DMA(t, slot) do { glds16(ksrc + (long)(t) * 64 * kpitch, (unsigned)__builtin_amdgcn_readfirstlane(kdst + (slot))); glds16(vsrc + (long)(t) * 64 * kpitch, (unsigned)__builtin_amdgcn_readfirstlane(vdst + (slot))); } while (0)
    const int vb0 = (int)(lds0 + L_V) + ((lane >> 4) & 1) * 32 + (lane & 3) * 8 + (4 * hi + ((lane & 15) >> 2)) * 64;
    const lds_cptr kp0 = (lds_cptr)shm + L_K + hi * 1024 + r32 * 16;
    const lds_cptr vp0 = (lds_cptr)shm + L_V + ((lane >> 4) & 1) * 32 + (lane & 3) * 8 + (4 * hi + ((lane & 15) >> 2)) * 64;
    if (!pre) {
#pragma unroll
        for (int d0 = 0; d0 < 4; ++d0) qr[d0] = *reinterpret_cast<const bf16x8*>(Qw + (long)r32 * qpitch + d0 * 16 + hi * 8);
    }
    asm volatile("s_waitcnt vmcnt(0)" ::: "memory");
#pragma unroll
    for (int d0 = 0; d0 < 4; ++d0) asm volatile("" : "+v"(qr[d0]));
    if (!pre) { ATT_DMA(j0, 0); if (j0 + 1 < NT) ATT_DMA(j0 + 1, SLOTB); if (j0 + 2 < NT) ATT_DMA(j0 + 2, 2 * SLOTB); }
    float m_run = -1e30f, l_run = 0.f; f32x16 o[2]; o[0] = f32x16{}; o[1] = f32x16{};
    int sl_cur = 0, sl_nxt = SLOTB, sl_nn = 2 * SLOTB, sl_n3 = 3 * SLOTB;
    const int qq = qq0 + r32;
    for (int j = j0; j < NT; ++j) {
        if (j + 2 < NT) { ATT_WAIT_BAR(4); } else if (j + 1 < NT) { ATT_WAIT_BAR(2); } else { ATT_WAIT_BAR(0); }
        if (j + 3 < NT) ATT_DMA(j + 3, sl_n3);
        if (j >= wlo && j <= whi) {
            f32x16 p0, p1;
            { const lds_cptr kb = kp0 + sl_cur; const f32x16 z = f32x16{};
#pragma unroll
              for (int d0 = 0; d0 < 4; ++d0) {
                  const bf16x8 b0 = *(const LAS bf16x8*)(kb + d0 * 2048), b1 = *(const LAS bf16x8*)(kb + d0 * 2048 + 512);
                  if (d0 == 0) { p0 = __builtin_amdgcn_mfma_f32_32x32x16_bf16(b0, qr[0], z, 0, 0, 0); p1 = __builtin_amdgcn_mfma_f32_32x32x16_bf16(b1, qr[0], z, 0, 0, 0); }
                  else { p0 = __builtin_amdgcn_mfma_f32_32x32x16_bf16(b0, qr[d0], p0, 0, 0, 0); p1 = __builtin_amdgcn_mfma_f32_32x32x16_bf16(b1, qr[d0], p1, 0, 0, 0); } } }
            VFrag vf; vload(vf, vp0 + sl_cur);
            if (MODE == 1) {
                const LAS float* bt = (const LAS float*)((LAS char*)shm + bias_off);
                const int jr = j - jrel0;
                if (jr <= 5) { const float b0 = bt[0];
#pragma unroll
                    for (int r = 0; r < 16; ++r) { p0[r] += b0; p1[r] += b0; } }
                else { const int base = 64 * (jr - 8) + 128 - qq + 4 * hi;
#pragma unroll
                    for (int r = 0; r < 16; ++r) { const int kv = (r & 3) + 8 * (r >> 2); int i0 = base + kv, i1 = base + kv + 32; i0 = i0 < 0 ? 0 : (i0 > 256 ? 256 : i0); i1 = i1 < 0 ? 0 : (i1 > 256 ? 256 : i1);
                        p0[r] += bt[i0]; p1[r] += bt[i1]; } }
            }
            if (SMP) { if (j == NT - 1) {
#pragma unroll
                for (int r = 0; r < 16; ++r) { if (crow(r, hi) >= 16) p0[r] = -1e30f; p1[r] = -1e30f; } } }
            const float rm = rowmax32(p0, p1);
            if (__any(rm > m_run + THR)) {
                const float mn = fmaxf(m_run, rm), alpha = __builtin_amdgcn_exp2f(m_run - mn); m_run = mn; l_run *= alpha;
                if (hi == 0) wsf[r32] = alpha;
                asm volatile("s_waitcnt lgkmcnt(0)" ::: "memory");
#pragma unroll
                for (int r = 0; r < 16; ++r) { const float f = wsf[crow(r, hi)]; o[0][r] *= f; o[1][r] *= f; }
            }
            float sa0 = 0.f, sa1 = 0.f, sa2 = 0.f, sa3 = 0.f;
#pragma unroll
            for (int r = 0; r < 16; r += 2) { p0[r] = __builtin_amdgcn_exp2f(p0[r] - m_run); p1[r] = __builtin_amdgcn_exp2f(p1[r] - m_run); p0[r + 1] = __builtin_amdgcn_exp2f(p0[r + 1] - m_run); p1[r + 1] = __builtin_amdgcn_exp2f(p1[r + 1] - m_run);
                sa0 += p0[r]; sa1 += p1[r]; sa2 += p0[r + 1]; sa3 += p1[r + 1]; }
            l_run += (sa0 + sa1) + (sa2 + sa3);
            u32x4 pw0, pw1, pw2, pw3;
            pw0 = (u32x4){cvt_pk_bf16(p0[0], p0[1]), cvt_pk_bf16(p0[2], p0[3]), cvt_pk_bf16(p0[4], p0[5]), cvt_pk_bf16(p0[6], p0[7])};
            pw1 = (u32x4){cvt_pk_bf16(p0[8], p0[9]), cvt_pk_bf16(p0[10], p0[11]), cvt_pk_bf16(p0[12], p0[13]), cvt_pk_bf16(p0[14], p0[15])};
            pw2 = (u32x4){cvt_pk_bf16(p1[0], p1[1]), cvt_pk_bf16(p1[2], p1[3]), cvt_pk_bf16(p1[4], p1[5]), cvt_pk_bf16(p1[6], p1[7])};
            pw3 = (u32x4){cvt_pk_bf16(p1[8], p1[9]), cvt_pk_bf16(p1[10], p1[11]), cvt_pk_bf16(p1[12], p1[13]), cvt_pk_bf16(p1[14], p1[15])};
            __builtin_amdgcn_sched_barrier(0);
            pv2(o, vf, __builtin_bit_cast(bf16x8, pw0), __builtin_bit_cast(bf16x8, pw1), __builtin_bit_cast(bf16x8, pw2), __builtin_bit_cast(bf16x8, pw3));
        }
        { const int t_ = sl_cur; sl_cur = sl_nxt; sl_nxt = sl_nn; sl_nn = sl_n3; sl_n3 = t_; }
    }
    asm volatile("s_waitcnt lgkmcnt(0)\n\ts_barrier" ::: "memory");
    if (has_next) {
        const bf16_t* ksrc_n = nx.Kt0 + koffl; const bf16_t* vsrc_n = nx.Vt0 + voffl;
        glds16(ksrc_n + (long)nx.j0 * 64 * kpitch, (unsigned)__builtin_amdgcn_readfirstlane(kdst)); glds16(vsrc_n + (long)nx.j0 * 64 * kpitch, (unsigned)__builtin_amdgcn_readfirstlane(vdst));
        if (nx.j0 + 1 < nx.NT) { glds16(ksrc_n + (long)(nx.j0 + 1) * 64 * kpitch, (unsigned)__builtin_amdgcn_readfirstlane(kdst + SLOTB)); glds16(vsrc_n + (long)(nx.j0 + 1) * 64 * kpitch, (unsigned)__builtin_amdgcn_readfirstlane(vdst + SLOTB)); }
        if (nx.j0 + 2 < nx.NT) { glds16(ksrc_n + (long)(nx.j0 + 2) * 64 * kpitch, (unsigned)__builtin_amdgcn_readfirstlane(kdst + 2 * SLOTB)); glds16(vsrc_n + (long)(nx.j0 + 2) * 64 * kpitch, (unsigned)__builtin_amdgcn_readfirstlane(vdst + 2 * SLOTB)); }
#pragma unroll
        for (int d0 = 0; d0 < 4; ++d0) qr[d0] = *reinterpret_cast<const bf16x8*>(nx.Qw + (long)r32 * qpitch + d0 * 16 + hi * 8);
    }
    { auto rr = __builtin_amdgcn_permlane32_swap(__float_as_uint(l_run), __float_as_uint(l_run), false, false); l_run = __uint_as_float(rr[0]) + __uint_as_float(rr[1]); }
    if (MODE == 0) l_run += __builtin_amdgcn_exp2f(sink2 - m_run);
    if (hi == 0) wsf[32 + r32] = l_run;
    asm volatile("s_waitcnt lgkmcnt(0)" ::: "memory");
    float rli[16];
#pragma unroll
    for (int r = 0; r < 16; ++r) rli[r] = __builtin_amdgcn_rcpf(wsf[32 + crow(r, hi)]);
    { LAS bf16_t* stg = (LAS bf16_t*)((LAS char*)shm + L_OST) + wid * 512;
#pragma unroll
      for (int q = 0; q < (SMP ? 2 : 4); ++q) {
#pragma unroll
          for (int rr = 0; rr < 4; ++rr) { const int r = 4 * q + rr, lrow = rr + 4 * hi;
#pragma unroll
              for (int d0 = 0; d0 < 2; ++d0) stg[lrow * 64 + d0 * 32 + r32] = (bf16_t)f2bf(o[d0][r] * rli[r]); }
          asm volatile("s_waitcnt lgkmcnt(0)" ::: "memory");
          { const int row = q * 8 + (lane >> 3), ch = lane & 7; const u32x4 v = *(const LAS u32x4*)(stg + (lane >> 3) * 64 + ch * 8); if (!SMP || wlo <= whi) *(u32x4*)(Ow + (long)row * AP + ch * 8) = v; }
          asm volatile("s_waitcnt lgkmcnt(0)" ::: "memory"); } }
    if (!has_next) asm volatile("s_waitcnt vmcnt(0) lgkmcnt(0)\n\ts_barrier" ::: "memory");
#undef ATT_DMA
}

struct AUB { const bf16_t* Qw; const bf16_t* Kt0; const bf16_t* Vt0; bf16_t* Ow; int j0; };
__device__ __forceinline__ void attn_unit_bw(char* shm, const AUB u, const bool pre, const bool has_next, const AUB nx, const int bias_off, const int qq0, bf16x8 (&qr)[4]) {
    const int tid = threadIdx.x, lane = tid & 63, r32 = lane & 31, hi = lane >> 5; const int wid = __builtin_amdgcn_readfirstlane(tid >> 6);
    const int co = wid >> 1, j0 = u.j0, s0 = j0 > 3 ? j0 - 3 : 0;
    const unsigned lds0 = (unsigned)(uintptr_t)shm;
    LAS float* wsf = (LAS float*)((LAS char*)shm + L_WS) + wid * 64;
    const long koffl = (long)lane * 64 + wid * 8, voffl = (long)(16 * (wid & 3) + (lane >> 2)) * 64 + (wid >> 2) * 32 + (lane & 3) * 8;
    const unsigned kdst = lds0 + L_K + wid * 1024, vdst = lds0 + L_V + wid * 1024;
#define ATT_SLOT(t) (((t) & 7) * SLOTB)
#define ATT_DMAB(U, t) do { const int sl_ = ATT_SLOT(t); glds16((U).Kt0 + koffl + (long)(t) * 4096, (unsigned)__builtin_amdgcn_readfirstlane(kdst + sl_)); glds16((U).Vt0 + voffl + (long)(t) * 4096, (unsigned)__builtin_amdgcn_readfirstlane(vdst + sl_)); } while (0)
    const int vb0 = (int)(lds0 + L_V) + ((lane >> 4) & 1) * 32 + (lane & 3) * 8 + (4 * hi + ((lane & 15) >> 2)) * 64;
    const lds_cptr kp0 = (lds_cptr)shm + L_K + hi * 1024 + r32 * 16;
    const lds_cptr vp0 = (lds_cptr)shm + L_V + ((lane >> 4) & 1) * 32 + (lane & 3) * 8 + (4 * hi + ((lane & 15) >> 2)) * 64;
    if (!pre) {
#pragma unroll
        for (int d0 = 0; d0 < 4; ++d0) qr[d0] = *reinterpret_cast<const bf16x8*>(u.Qw + (long)r32 * 64 + d0 * 16 + hi * 8);
    }
    asm volatile("s_waitcnt vmcnt(0)" ::: "memory");
#pragma unroll
    for (int d0 = 0; d0 < 4; ++d0) asm volatile("" : "+v"(qr[d0]));
    if (!pre) { for (int t = j0; t <= s0 + 6 && t <= 11; ++t) ATT_DMAB(u, t); }
    float m_run = 0.f, l_run = 0.f; f32x16 o[2]; o[0] = f32x16{}; o[1] = f32x16{};
    bool fresh = true;
    const int qq = qq0 + r32;
    const LAS float* bt = (const LAS float*)((LAS char*)shm + bias_off);
    const float bfar = bt[0];
    for (int s = s0; s < 9; ++s) {
        if (s <= 5) { ATT_WAIT_BAR(6); } else if (s == 6) { ATT_WAIT_BAR(4); } else if (s == 7) { ATT_WAIT_BAR(2); } else { ATT_WAIT_BAR(0); }
        if (s + 7 <= 11) ATT_DMAB(u, s + 7);
        const int t = s + co;
        if (t >= j0) {
            const int sl = ATT_SLOT(t);
            f32x16 p0, p1;
            { const lds_cptr kb = kp0 + sl; const float c0 = (s <= 5 ? bfar : 0.f) - m_run; f32x16 z;
#pragma unroll
              for (int r = 0; r < 16; ++r) z[r] = c0;
#pragma unroll
              for (int d0 = 0; d0 < 4; ++d0) {
                  const bf16x8 b0 = *(const LAS bf16x8*)(kb + d0 * 2048), b1 = *(const LAS bf16x8*)(kb + d0 * 2048 + 512);
                  if (d0 == 0) { p0 = __builtin_amdgcn_mfma_f32_32x32x16_bf16(b0, qr[0], z, 0, 0, 0); p1 = __builtin_amdgcn_mfma_f32_32x32x16_bf16(b1, qr[0], z, 0, 0, 0); }
                  else { p0 = __builtin_amdgcn_mfma_f32_32x32x16_bf16(b0, qr[d0], p0, 0, 0, 0); p1 = __builtin_amdgcn_mfma_f32_32x32x16_bf16(b1, qr[d0], p1, 0, 0, 0); } } }
            VFrag vf; vload(vf, vp0 + sl);
            if (s == 6) { const int base = 64 * (6 - 8) + 128 - qq + 4 * hi;
#pragma unroll
                for (int r = 0; r < 16; ++r) { const int kv = (r & 3) + 8 * (r >> 2); int i0 = base + kv, i1 = base + kv + 32; i0 = i0 < 0 ? 0 : i0; i1 = i1 < 0 ? 0 : i1; p0[r] += bt[i0]; p1[r] += bt[i1]; } }
            else if (s >= 7) { const LAS float* bb = bt + (64 * (s - 8) + 128 - qq + 4 * hi);
#pragma unroll
                for (int r = 0; r < 16; ++r) { const int kv = (r & 3) + 8 * (r >> 2); p0[r] += bb[kv]; p1[r] += bb[kv + 32]; } }
            const float rm = rowmax32(p0, p1);
            if (fresh || __any(rm > THR)) {
                const float dl = fresh ? rm : fmaxf(rm, 0.f), alpha = __builtin_amdgcn_exp2f(-dl); m_run += dl; l_run *= alpha; fresh = false;
#pragma unroll
                for (int r = 0; r < 16; ++r) { p0[r] -= dl; p1[r] -= dl; }
                if (hi == 0) wsf[r32] = alpha;
                asm volatile("s_waitcnt lgkmcnt(0)" ::: "memory");
#pragma unroll
                for (int r = 0; r < 16; ++r) { const float f = wsf[crow(r, hi)]; o[0][r] *= f; o[1][r] *= f; }
            }
            float sa0 = 0.f, sa1 = 0.f, sa2 = 0.f, sa3 = 0.f;
#pragma unroll
            for (int r = 0; r < 16; r += 2) { p0[r] = __builtin_amdgcn_exp2f(p0[r]); p1[r] = __builtin_amdgcn_exp2f(p1[r]); p0[r + 1] = __builtin_amdgcn_exp2f(p0[r + 1]); p1[r + 1] = __builtin_amdgcn_exp2f(p1[r + 1]);
                sa0 += p0[r]; sa1 += p1[r]; sa2 += p0[r + 1]; sa3 += p1[r + 1]; }
            l_run += (sa0 + sa1) + (sa2 + sa3);
            u32x4 pw0, pw1, pw2, pw3;
            pw0 = (u32x4){cvt_pk_bf16(p0[0], p0[1]), cvt_pk_bf16(p0[2], p0[3]), cvt_pk_bf16(p0[4], p0[5]), cvt_pk_bf16(p0[6], p0[7])};
            pw1 = (u32x4){cvt_pk_bf16(p0[8], p0[9]), cvt_pk_bf16(p0[10], p0[11]), cvt_pk_bf16(p0[12], p0[13]), cvt_pk_bf16(p0[14], p0[15])};
            pw2 = (u32x4){cvt_pk_bf16(p1[0], p1[1]), cvt_pk_bf16(p1[2], p1[3]), cvt_pk_bf16(p1[4], p1[5]), cvt_pk_bf16(p1[6], p1[7])};
            pw3 = (u32x4){cvt_pk_bf16(p1[8], p1[9]), cvt_pk_bf16(p1[10], p1[11]), cvt_pk_bf16(p1[12], p1[13]), cvt_pk_bf16(p1[14], p1[15])};
            __builtin_amdgcn_sched_barrier(0);
            pv2(o, vf, __builtin_bit_cast(bf16x8, pw0), __builtin_bit_cast(bf16x8, pw1), __builtin_bit_cast(bf16x8, pw2), __builtin_bit_cast(bf16x8, pw3));
        }
    }
    asm volatile("s_waitcnt lgkmcnt(0)\n\ts_barrier" ::: "memory");
    if (has_next) {
        const int nj0 = nx.j0, ns0 = nj0 > 3 ? nj0 - 3 : 0;
        for (int t = nj0; t <= ns0 + 6 && t <= 11; ++t) ATT_DMAB(nx, t);
#pragma unroll
        for (int d0 = 0; d0 < 4; ++d0) qr[d0] = *reinterpret_cast<const bf16x8*>(nx.Qw + (long)r32 * 64 + d0 * 16 + hi * 8);
    }
    { auto rr = __builtin_amdgcn_permlane32_swap(__float_as_uint(l_run), __float_as_uint(l_run), false, false); l_run = __uint_as_float(rr[0]) + __uint_as_float(rr[1]); }
    if (hi == 0) wsf[32 + r32] = l_run;
    asm volatile("s_waitcnt lgkmcnt(0)" ::: "memory");
    float rli[16];
#pragma unroll
    for (int r = 0; r < 16; ++r) rli[r] = __builtin_amdgcn_rcpf(wsf[32 + crow(r, hi)]);
    { LAS bf16_t* stg = (LAS bf16_t*)((LAS char*)shm + L_OST) + wid * 512;
#pragma unroll
      for (int q = 0; q < 4; ++q) {
#pragma unroll
          for (int rr = 0; rr < 4; ++rr) { const int r = 4 * q + rr, lrow = rr + 4 * hi;
#pragma unroll
              for (int d0 = 0; d0 < 2; ++d0) stg[lrow * 64 + d0 * 32 + r32] = (bf16_t)f2bf(o[d0][r] * rli[r]); }
          asm volatile("s_waitcnt lgkmcnt(0)" ::: "memory");
          { const int row = q * 8 + (lane >> 3), ch = lane & 7; const u32x4 v = *(const LAS u32x4*)(stg + (lane >> 3) * 64 + ch * 8); *(u32x4*)(u.Ow + (long)row * AP + ch * 8) = v; }
          asm volatile("s_waitcnt lgkmcnt(0)" ::: "memory"); } }
    if (!has_next) asm volatile("s_waitcnt vmcnt(0) lgkmcnt(0)\n\ts_barrier" ::: "memory");
#undef ATT_DMAB
#undef ATT_SLOT
}
}

#define XB_TMO      128
#define XB_XCNT(j)  (256  + 64 * (j))
#define XB_XSUB(j)  (1280 + 64 * (j))
#define XB_XGEN(j)  (2304 + 64 * (j))
#define XB_TOP      3328
#define XB_TOPGEN   3392
#define XCD_BAR_WORDS 3456
#define XB_SPIN_CAP (1u << 20)
__device__ __forceinline__ unsigned xb_ld(unsigned* p)              { return __hip_atomic_load(p, __ATOMIC_RELAXED, __HIP_MEMORY_SCOPE_AGENT); }
__device__ __forceinline__ unsigned xb_add(unsigned* p, unsigned v) { return __hip_atomic_fetch_add(p, v, __ATOMIC_RELAXED, __HIP_MEMORY_SCOPE_AGENT); }
__device__ __forceinline__ unsigned xb_xcc_id() { return (unsigned)__builtin_amdgcn_s_getreg((3 << 11) | 20) & 0xFu; }
#define XB_SPIN(cond, bar) do { unsigned _sp = 0; while (cond) { __builtin_amdgcn_s_sleep(1); \
    if ((++_sp & 255u) == 0u) { if (xb_ld(&(bar)[XB_TMO])) break; if (_sp > XB_SPIN_CAP) { atomicAdd(&(bar)[XB_TMO], 1u); break; } } } } while (0)
struct XcdBarrier { unsigned* bar; unsigned x; volatile LAS unsigned* st; };
__device__ __forceinline__ XcdBarrier xcd_barrier_post(unsigned* bar, volatile LAS unsigned* st) {
    XcdBarrier b; b.bar = bar; b.x = xb_xcc_id(); b.st = st;
    if (threadIdx.x == 0) (void)xb_add(&bar[XB_XCNT(b.x)], 1u);
    return b;
}
__device__ __forceinline__ void xcd_barrier_complete(unsigned* bar, unsigned x, unsigned& nloc, unsigned& nx) {
    const unsigned G = gridDim.x * gridDim.y * gridDim.z;
    unsigned sum, cnt, mine, sp = 0u;
    for (;;) {
        sum = 0u; cnt = 0u; mine = 0u;
#pragma unroll
        for (unsigned j = 0; j < 16; ++j) { const unsigned c = xb_ld(&bar[XB_XCNT(j)]); sum += c; cnt += (c > 0u) ? 1u : 0u; mine = (j == x) ? c : mine; }
        if (sum == G) break;
        __builtin_amdgcn_s_sleep(1);
        if ((++sp & 255u) == 0u) { if (xb_ld(&bar[XB_TMO])) break; if (sp > XB_SPIN_CAP) { atomicAdd(&bar[XB_TMO], 1u); break; } }
    }
    nloc = mine > 0u ? mine : 1u; nx = cnt > 0u ? cnt : 1u;
}
__device__ __forceinline__ void xcd_barrier(const XcdBarrier& b) {
    asm volatile("s_waitcnt vmcnt(0)" ::: "memory");
    __syncthreads();
    if (threadIdx.x == 0) {
        unsigned* bar = b.bar;
        __builtin_amdgcn_s_waitcnt(0);
        unsigned nloc = b.st[0], nx = b.st[1];
        if (nloc == 0u) { xcd_barrier_complete(bar, b.x, nloc, nx); b.st[0] = nloc; b.st[1] = nx; }
        const unsigned old = xb_add(&bar[XB_XSUB(b.x)], 1u);
        const unsigned gen = old / nloc;
        if (old + 1u == (gen + 1u) * nloc) {
            __builtin_amdgcn_fence(__ATOMIC_RELEASE, "agent");
            asm volatile("s_waitcnt vmcnt(0)" ::: "memory");
            const unsigned og = xb_add(&bar[XB_TOP], 1u);
            const unsigned tg = og / nx;
            if (og + 1u == (tg + 1u) * nx) xb_add(&bar[XB_TOPGEN], 1u);
            else XB_SPIN(xb_ld(&bar[XB_TOPGEN]) == tg, bar);
            __builtin_amdgcn_fence(__ATOMIC_ACQUIRE, "agent");
            xb_add(&bar[XB_XGEN(b.x)], 1u);
            asm volatile("s_waitcnt vmcnt(0)" ::: "memory");
        } else {
            XB_SPIN(xb_ld(&bar[XB_XGEN(b.x)]) == gen, bar);
            __builtin_amdgcn_fence(__ATOMIC_ACQUIRE, "agent");
            asm volatile("s_waitcnt vmcnt(0)" ::: "memory");
        }
    }
    __syncthreads();
}

struct Args { const float* in[21]; float* out; unsigned char* ws; int ph_lo, ph_hi; };
struct Frame {
    LAS unsigned char* lds; int tid, lane, wave, vcu, G;
    const float* in[21]; float* out; unsigned char* ws;
};
#define LDS_WAIT() asm volatile("s_waitcnt lgkmcnt(0)" ::: "memory")
#define VM_WAIT() asm volatile("s_waitcnt vmcnt(0)" ::: "memory")

__device__ __forceinline__ void transpose_item(const float* W, int N, bf16_t* WT, int ldd, int koff, int kind, LAS float* scr, int item, int lane, const float* gk = nullptr) {
    const int nblk = N / 32, kb = item / nblk, nb = item % nblk, k0 = 64 * kb, n0 = 32 * nb;
#pragma unroll 8
    for (int i = 0; i < 32; ++i) { const int kk = 2 * i + (lane >> 5); scr[kk * 33 + (lane & 31)] = W[(size_t)(k0 + kk) * N + n0 + (lane & 31)] * (gk ? gk[k0 + kk] : 1.0f); }
    LDS_WAIT(); asm volatile("" ::: "memory");
    const int c = lane & 7;
#pragma unroll
    for (int j = 0; j < 4; ++j) { const int n = (lane >> 3) + 8 * j; const LAS float* s = scr + (8 * c) * 33 + n;
        u32x4 o; o.x = pk2(s[0 * 33], s[1 * 33]); o.y = pk2(s[2 * 33], s[3 * 33]); o.z = pk2(s[4 * 33], s[5 * 33]); o.w = pk2(s[6 * 33], s[7 * 33]);
        const int nn = n0 + n; const int dr = kind == 1 ? gcol_in(nn) : (kind == 2 ? gcol_up(nn) : nn);
        *(u32x4*)(WT + (size_t)dr * ldd + koff + k0 + 8 * c) = o; }
    LDS_WAIT(); asm volatile("" ::: "memory");
}
__device__ __forceinline__ void rms_row_to_bf16(const float* xrow, const float* g, bf16_t* orow, int lane) {
    const f32x4* xr = (const f32x4*)xrow + lane; const f32x4* gr = (const f32x4*)g + lane;
    f32x4 v[4]; float s = 0.f;
#pragma unroll
    for (int j = 0; j < 4; ++j) { v[j] = xr[64 * j]; s += (v[j].x * v[j].x + v[j].y * v[j].y) + (v[j].z * v[j].z + v[j].w * v[j].w); }
    const float rstd = 1.0f / sqrtf(wave_sum(s) * (1.f / DM) + EPS);
    unsigned long long* o8 = (unsigned long long*)orow + lane;
#pragma unroll
    for (int j = 0; j < 4; ++j) { const f32x4 gg = gr[64 * j]; const f32x4 y = v[j] * rstd * gg; o8[64 * j] = (unsigned long long)pk2(y.x, y.y) | ((unsigned long long)pk2(y.z, y.w) << 32); }
}
__device__ __forceinline__ const float* xrow_ptr(const Frame& F, int m) { return m < MP ? F.in[0] + (size_t)m * DM : F.in[1] + (size_t)(m - MP) * DM; }
__device__ __forceinline__ float* yrow_ptr(const Frame& F, int m) { return m < MP ? F.out + O_YP + (size_t)m * DM : F.out + O_YS + (size_t)(m - MP) * DM; }

__device__ __forceinline__ f32x4 skinny(const bf16_t* A, int lda, const bf16_t* Bt, int ldb, int n0, int wave, int lane, int K, LAS unsigned char* red) {
    const int fr = lane & 15, fq = lane >> 4, kw = K >> 3;
    const bf16_t* ap = A + (size_t)fr * lda + wave * kw + 8 * fq; const bf16_t* bp = Bt + (size_t)(n0 + fr) * ldb + wave * kw + 8 * fq;
    f32x4 acc[8];
#pragma unroll
    for (int rb = 0; rb < 8; ++rb) acc[rb] = (f32x4){0.f, 0.f, 0.f, 0.f};
    int k0 = 0;
#pragma nounroll
    for (; k0 + 64 <= kw; k0 += 64) {
        bf16x8 b[2], a[2][8];
#pragma unroll
        for (int i = 0; i < 2; ++i) { b[i] = *(const bf16x8*)(bp + k0 + 32 * i);
#pragma unroll
            for (int rb = 0; rb < 8; ++rb) a[i][rb] = *(const bf16x8*)(ap + (size_t)(16 * rb) * lda + k0 + 32 * i); }
        __builtin_amdgcn_sched_barrier(0);
#pragma unroll
        for (int i = 0; i < 2; ++i)
#pragma unroll
            for (int rb = 0; rb < 8; ++rb) acc[rb] = __builtin_amdgcn_mfma_f32_16x16x32_bf16(a[i][rb], b[i], acc[rb], 0, 0, 0);
    }
#pragma nounroll
    for (; k0 < kw; k0 += 32) {
        const bf16x8 b = *(const bf16x8*)(bp + k0); bf16x8 a[8];
#pragma unroll
        for (int rb = 0; rb < 8; ++rb) a[rb] = *(const bf16x8*)(ap + (size_t)(16 * rb) * lda + k0);
        __builtin_amdgcn_sched_barrier(0);
#pragma unroll
        for (int rb = 0; rb < 8; ++rb) acc[rb] = __builtin_amdgcn_mfma_f32_16x16x32_bf16(a[rb], b, acc[rb], 0, 0, 0);
    }
    LAS f32x4* R = (LAS f32x4*)red;
#pragma unroll
    for (int rb = 0; rb < 8; ++rb) R[(wave * 8 + rb) * 64 + lane] = acc[rb];
    __syncthreads();
    f32x4 r = R[(0 * 8 + wave) * 64 + lane];
#pragma unroll
    for (int w2 = 1; w2 < 8; ++w2) r += R[(w2 * 8 + wave) * 64 + lane];
    __syncthreads();
    return r;
}

__global__ void __launch_bounds__(512, 2) fwd_kernel(Args args) {
    extern __shared__ __attribute__((aligned(16))) unsigned char lds_raw[];
    Frame F;
    F.lds = (LAS unsigned char*)lds_raw;
    F.tid = threadIdx.x; F.lane = F.tid & 63; F.wave = __builtin_amdgcn_readfirstlane(F.tid >> 6);
    F.G = gridDim.x; { const int bx = blockIdx.x; F.vcu = (F.G % 8 == 0) ? (bx % 8) * (F.G / 8) + bx / 8 : bx; }
#pragma unroll
    for (int i = 0; i < 21; ++i) F.in[i] = args.in[i];
    F.out = args.out; F.ws = args.ws;
    unsigned char* ws = args.ws;
    unsigned* ctl = (unsigned*)(ws + WS_CTL);
    volatile LAS unsigned* MISC = (volatile LAS unsigned*)(F.lds + MISC_OFF);
    for (int u = F.tid; u < 64; u += 512) MISC[u] = 0u;
    __syncthreads();
    const int lo = args.ph_lo, hi = args.ph_hi;
    const bool one_launch = (hi - lo) > 1;
    XcdBarrier bar; bar.bar = ctl + CW_BAR; bar.x = 0; bar.st = nullptr;
    if (one_launch) bar = xcd_barrier_post(ctl + CW_BAR, MISC + 8);
#define IN(k) (lo <= (k) && (k) < hi)
#define RSYNC(S, k) do { if (one_launch) { (S).nloc = MISC[8]; (S).rcnt = ctl + CW_ROUND + 1024 * (k) + 64 * bar.x; if ((S).nloc == 0u) (S).rcnt = nullptr; } } while (0)
#define GRID_BAR(k) do { if (IN(k) && IN((k) + 1)) xcd_barrier(bar); } while (0)
    bf16_t* Win_t = (bf16_t*)(ws + WS_WIN); bf16_t* Woab_t = (bf16_t*)(ws + WS_WOAB); bf16_t* Wout_t = (bf16_t*)(ws + WS_WOUT); bf16_t* Wup_t = (bf16_t*)(ws + WS_WUP); bf16_t* Wd_t = (bf16_t*)(ws + WS_WD);
    float* CS = (float*)(ws + WS_CS); float* S1 = (float*)(ws + WS_S1); bf16_t* SKV = (bf16_t*)(ws + WS_SKV); float* RSTD0 = (float*)(ws + WS_RSTD0); float* RSTD1 = (float*)(ws + WS_RSTD1); bf16_t* SQ = (bf16_t*)(ws + WS_SQ);
    float* uhalo = (float*)(ws + WS_UHALO); float* fixu = (float*)(ws + WS_FIXU); float* fixv = (float*)(ws + WS_FIXV);
    bf16_t* XN = (bf16_t*)(ws + WS_XN); bf16_t* QKV = (bf16_t*)(ws + WS_QKV); bf16_t* GB = (bf16_t*)(ws + WS_G); bf16_t* OB = (bf16_t*)(ws + WS_O);
    bf16_t* X1B = (bf16_t*)(ws + WS_X1B); bf16_t* MIX = (bf16_t*)(ws + WS_QKV); bf16_t* GT = (bf16_t*)(ws + WS_QKV); bf16_t* ZB = (bf16_t*)(ws + WS_O); bf16_t* FB = (bf16_t*)(ws + WS_O);
    const int gw = F.vcu * 8 + F.wave, NGW = F.G * 8;
    LAS unsigned char* ring = F.lds; LAS unsigned char* xlds = F.lds + XLDS_OFF;

    if (IN(0)) for (int rep_ = 0; rep_ <= ((REPEAT_MASK >> 0) & 1); ++rep_) {
        LAS float* scr = (LAS float*)(F.lds + F.wave * 16384);
        constexpr int I_IN = 16 * (NIN / 32), I_OA = 8 * 32, I_OUT = 16 * 32, I_UP = 16 * (NUP / 32), I_D = (FF / 64) * 32;
        constexpr int NITEMS = I_IN + 2 * I_OA + I_OUT + I_UP + I_D;
        for (int it = gw; it < NITEMS; it += NGW) {
            int r = it;
            if (r < I_IN) { transpose_item(F.in[8], NIN, Win_t, AP, 0, 1, scr, r, F.lane, F.in[7]); continue; } r -= I_IN;
            if (r < I_OA) { transpose_item(F.in[11], DM, Woab_t, AP, 0, 0, scr, r, F.lane); continue; } r -= I_OA;
            if (r < I_OA) { transpose_item(F.in[12], DM, Woab_t, AP, 512, 0, scr, r, F.lane); continue; } r -= I_OA;
            if (r < I_OUT) { transpose_item(F.in[13], DM, Wout_t, AP, 0, 0, scr, r, F.lane); continue; } r -= I_OUT;
            if (r < I_UP) { transpose_item(F.in[16], NUP, Wup_t, AP, 0, 2, scr, r, F.lane, F.in[15]); continue; } r -= I_UP;
            transpose_item(F.in[19], DM, Wd_t, GTP, 0, 0, scr, r, F.lane);
        }
        for (int e = blockIdx.x * 512 + F.tid; e < SEQ * 32; e += F.G * 512) {
          { const int t = e >> 5, d = e & 31; const float inv = 1.0f / powf(10000.0f, (float)d * (2.0f / 64.0f)); const float ang = (float)t * inv;
              CS[(size_t)t * 64 + d] = cosf(ang); CS[(size_t)t * 64 + 32 + d] = sinf(ang); } }
        for (int it = gw; it < SB * SKVR; it += NGW) {
            const int b = it / SKVR, j = it % SKVR, l = F.lane; bf16_t* dst = SKV + (size_t)it * SKVP;
            if (j < 512) {
                const f32x4* kb = (const f32x4*)(F.in[4] + (size_t)(b * 512 + j) * 512); const f32x4* vb = (const f32x4*)(F.in[5] + (size_t)(b * 512 + j) * 512);
#pragma unroll
                for (int i = 0; i < 2; ++i) { const f32x4 a = kb[l + 64 * i], c = vb[l + 64 * i];
                    *(u32x2*)(dst + 4 * (l + 64 * i)) = (u32x2){pk2(a.x, a.y), pk2(a.z, a.w)}; *(u32x2*)(dst + 512 + 4 * (l + 64 * i)) = (u32x2){pk2(c.x, c.y), pk2(c.z, c.w)}; }
                if (j >= 384 && l < 32) {
                    const int g = l >> 4, i = l & 15, d0 = 4 * (i >> 1) + 32 * (i & 1);
                    const f32x4 a = *(const f32x4*)(F.in[2] + ((size_t)(b * 128 + (j - 384)) * 2 + g) * 64 + d0); const f32x4 c = *(const f32x4*)(F.in[3] + ((size_t)(b * 128 + (j - 384)) * 2) * 64 + 4 * l);
                    *(u32x2*)(dst + 1024 + 4 * l) = (u32x2){pk2(a.x, a.y), pk2(a.z, a.w)}; *(u32x2*)(dst + 1152 + 4 * l) = (u32x2){pk2(c.x, c.y), pk2(c.z, c.w)}; }
            } else if (j >= 528) {
#pragma unroll
                for (int i = 0; i < 5; ++i) *(u32x2*)(dst + 4 * (l + 64 * i)) = (u32x2){0u, 0u};
            }
        }
        for (int m0 = gw; m0 < MP + MS; m0 += 4 * NGW) {
            f32x4 v[4][4];
#pragma unroll
            for (int r = 0; r < 4; ++r) { const int m = m0 + r * NGW; const f32x4* xr = (const f32x4*)xrow_ptr(F, m < MP + MS ? m : m0) + F.lane;
#pragma unroll
                for (int j = 0; j < 4; ++j) v[r][j] = xr[64 * j]; }
            __builtin_amdgcn_sched_barrier(0);
#pragma unroll
            for (int r = 0; r < 4; ++r) { const int m = m0 + r * NGW; if (m >= MP + MS) break;
                float s = 0.f;
#pragma unroll
                for (int j = 0; j < 4; ++j) s += (v[r][j].x * v[r][j].x + v[r][j].y * v[r][j].y) + (v[r][j].z * v[r][j].z + v[r][j].w * v[r][j].w);
                const float rstd = 1.0f / sqrtf(wave_sum(s) * (1.f / DM) + EPS);
                if (F.lane == 0) RSTD0[m] = rstd;
                unsigned long long* o8 = (unsigned long long*)(XN + (size_t)m * AP) + F.lane;
#pragma unroll
                for (int j = 0; j < 4; ++j) { const f32x4 y = v[r][j]; o8[64 * j] = (unsigned long long)pk2(y.x, y.y) | ((unsigned long long)pk2(y.z, y.w) << 32); } }
        }
    }
    GRID_BAR(0);

    if (IN(1)) {
        for (int rs_ = 0; rs_ <= PROBE_SMP; ++rs_) for (int s = F.vcu; s < NIN / 16; s += F.G) {
            const int n0 = 16 * s; const f32x4 acc = skinny(XN + (size_t)MP * AP, AP, Win_t, AP, n0, F.wave, F.lane, DM, ring);
            const int fr = F.lane & 15, fq = F.lane >> 4, gc = n0 + fr, b = F.wave;
#pragma unroll
            for (int reg = 0; reg < 4; ++reg) {
                const int t = 4 * fq + reg, row = 16 * b + t; float val = acc[reg] * RSTD0[MP + row];
                const float partner = __shfl_xor(val, 4);
                if (gc < 640) {
                    const int j = gc & 63, q = j >> 3, e = j & 7, dd = 4 * q + (e & 3); const float cs = CS[(size_t)(PAST + t) * 64 + dd], sn = CS[(size_t)(PAST + t) * 64 + 32 + dd];
                    val = (e < 4) ? (val * cs - partner * sn) : (val * cs + partner * sn);
                }
                const int sc = src_in(gc);
                S1[(size_t)row * NIN + sc] = val;
                { bf16_t* kvr = SKV + ((size_t)b * SKVR + 512 + t) * SKVP;
                  if (gc < 512) SQ[(size_t)row * SQP + gc] = (bf16_t)f2bf(val * C2);
                  else if (gc < 640) kvr[1024 + (gc - 512)] = (bf16_t)f2bf(val);
                  else if (gc < 768) kvr[1152 + (gc - 640)] = (bf16_t)f2bf(val);
                  else if (gc < 1280) SQ[(size_t)row * SQP + 512 + (gc - 768)] = (bf16_t)f2bf(val * C2);
                  else if (gc < 1792) kvr[gc - 1280] = (bf16_t)f2bf(val);
                  else if (gc < 2304) kvr[512 + (gc - 1792)] = (bf16_t)f2bf(val); }
                if (sc >= 512 && sc < 640) F.out[O_AKS + (size_t)row * 128 + (sc - 512)] = val;
                else if (sc >= 640 && sc < 768) F.out[O_AVS + (size_t)row * 128 + (sc - 640)] = val;
                else if (sc >= 1280 && sc < 1792) F.out[O_BKS + (size_t)row * 512 + (sc - 1280)] = val;
                else if (sc >= 1792 && sc < 2304) F.out[O_BVS + (size_t)row * 512 + (sc - 1792)] = val;
            }
        }
        pg8::Gemm g{XN, Win_t, MP, NIN, DM, AP, AP}; pg8::StaticOrder S; S.init(MP, NIN, F.G, (int)blockIdx.x, 1 + ((REPEAT_MASK >> 1) & 1)); S.sub_n = PROBE_SUB_N; S.sub_o = PROBE_SUB_O; RSYNC(S, 1);
        pg8::EpiIn E{QKV, GB, CS, F.out, RSTD0};
        pg8::gemm_phase<pg8::EpiIn, pg8::StaticOrder>(ring, xlds, g, S, E);
    }
    GRID_BAR(1);

    if (IN(2)) for (int rep_ = 0; rep_ <= ((REPEAT_MASK >> 2) & 1); ++rep_) {
        char* shm = (char*)lds_raw;
        { LAS float* bt = (LAS float*)(F.lds + att::L_BIAS); const int h0 = F.vcu & 7, h1 = (F.vcu >> 1) & 7;
          for (int i = F.tid; i < 2 * 257; i += 512) { const int wh = i / 257, k = i % 257; bt[wh * 260 + k] = F.in[10][(wh ? h1 : h0) * 257 + k] * LOG2E; }
          LAS float* sk = (LAS float*)(F.lds + att::L_SINK); if (F.tid < 8) sk[F.tid] = F.in[9][F.tid] * LOG2E; }
        __syncthreads();
        bf16x8 qr[4];
        if (F.vcu < 64) {
            const int b = F.vcu >> 3, h = F.vcu & 7, act = (F.wave == 0);
            const bf16_t* kv = SKV + (size_t)b * SKVR * SKVP;
            const att::AU u{SQ + (size_t)(16 * b) * SQP + 512 + 64 * h, kv + 64 * h, kv + 512 + 64 * h, OB + (size_t)(MP + 16 * b) * AP + 512 + 64 * h, 0, 9, act ? 0 : 1, act ? 8 : 0, 0.f, att::L_BIAS, 0, 0};
            att::attn_unit<1, true>(shm, u, SKVP, SQP, false, false, u, qr);
        } else if (F.vcu < 80) {
            const int b = (F.vcu - 64) >> 1, g = F.vcu & 1, act = (F.wave < 4), hq = 4 * g + (F.wave & 3);
            const LAS float* sk = (const LAS float*)(F.lds + att::L_SINK);
            const bf16_t* kv = SKV + ((size_t)b * SKVR + 384) * SKVP;
            const att::AU u{SQ + (size_t)(16 * b) * SQP + 64 * hq, kv + 1024 + 64 * g, kv + 1152 + 64 * g, OB + (size_t)(MP + 16 * b) * AP + 64 * hq, 0, 3, act ? 0 : 1, act ? 2 : 0, sk[hq], 0, 0, 0};
            att::attn_unit<0, true>(shm, u, SKVP, SQP, false, false, u, qr);
        }
        {
            const int bh = F.vcu >> 1, b = bh >> 3, h = bh & 7, par = F.vcu & 1, w = F.wave, wl = w >> 1;
            auto descB = [&](int i) { const int pr = i >> 1, od = i & 1; const int qb = 4 * pr + (par == 0 ? (od ? 3 : 0) : (od ? 2 : 1));
                const int tq = 256 * qb + 32 * w, tk0 = 64 * (4 * qb - 8); const int j0 = (8 - 4 * qb) > 0 ? (8 - 4 * qb) : 0;
                return att::AUB{QKV + H_QB + hm_off(8, b, h, 0) + (long)tq * 64, QKV + H_KB + hm_off(8, b, h, 0) + (long)tk0 * 64, QKV + H_VB + hm_off(8, b, h, 0) + (long)tk0 * 64, OB + ((long)b * SEQ + tq) * AP + 512 + 64 * h, j0}; };
            for (int rb_ = 0; rb_ <= (REPEAT_ATT & 1); ++rb_)
            for (int i = 0; i < 8; ++i) att::attn_unit_bw(shm, descB(i), i > 0, i < 7, descB(i < 7 ? i + 1 : i), att::L_BIAS + 260 * 4, 32 * (w & 1), qr);
        }
        {
            const int b = F.vcu >> 4, w = F.wave; const LAS float* sk = (const LAS float*)(F.lds + att::L_SINK);
            auto descA = [&](int i) { const int c = 4 * (F.vcu & 15) + (i >> 1), g = i & 1, hq = 4 * g + (w >> 1);
                const int tq = 64 * c + 32 * (w & 1), tk0 = 64 * (c - 2); const int j0 = (2 - c) > 0 ? (2 - c) : 0;
                return att::AU{QKV + H_QA + hm_off(8, b, hq, 0) + (long)tq * 64, QKV + H_KA + hm_off(2, b, g, 0) + (long)tk0 * 64, QKV + H_VA + hm_off(2, b, g, 0) + (long)tk0 * 64, OB + ((long)b * SEQ + tq) * AP + 64 * hq, j0, 3, j0, 2, sk[hq], 0, 0, 0}; };
            for (int ra_ = 0; ra_ <= ((REPEAT_ATT >> 1) & 1); ++ra_)
            for (int i = 0; i < 8; ++i) att::attn_unit<0, false>(shm, descA(i), 64, 64, i > 0, i < 7, descA(i < 7 ? i + 1 : i), qr);
        }
    }
    GRID_BAR(2);

    if (IN(3)) {
        for (int rs_ = 0; rs_ <= PROBE_SMP; ++rs_) for (int s = F.vcu; s < DM / 16; s += F.G) {
            const int n0 = 16 * s, fr = F.lane & 15, fq = F.lane >> 4;
            const f32x4 aa = skinny(OB + (size_t)MP * AP, AP, Woab_t, AP, n0, F.wave, F.lane, 512, ring), ab = skinny(OB + (size_t)MP * AP + 512, AP, Woab_t + 512, AP, n0, F.wave, F.lane, 512, ring);
#pragma unroll
            for (int reg = 0; reg < 4; ++reg) { const int row = 16 * F.wave + 4 * fq + reg; const float ga = S1[(size_t)row * NIN + 2304 + n0 + fr], gb = S1[(size_t)row * NIN + 3328 + n0 + fr];
                MIX[(size_t)(MP + row) * AP + n0 + fr] = (bf16_t)f2bf(sigmoidf_(ga) * aa[reg] + sigmoidf_(gb) * ab[reg]); }
        }
        pg8::Gemm g{OB, Woab_t, MP, DM, DM, AP, AP}; pg8::StaticOrder S; S.init(MP, DM, F.G, (int)blockIdx.x, 1 + ((REPEAT_MASK >> 3) & 1)); RSYNC(S, 3);
        pg8::EpiGate E{GB, MIX};
        pg8::gemm_phase<pg8::EpiGate, pg8::StaticOrder>(ring, xlds, g, S, E);
    }
    GRID_BAR(3);

    if (IN(4)) {
        for (int rs_ = 0; rs_ <= PROBE_SMP; ++rs_) for (int s = F.vcu; s < DM / 16; s += F.G) {
            const int n0 = 16 * s; const f32x4 acc = skinny(MIX + (size_t)MP * AP, AP, Wout_t, AP, n0, F.wave, F.lane, DM, ring);
            const int fr = F.lane & 15, fq = F.lane >> 4;
#pragma unroll
            for (int reg = 0; reg < 4; ++reg) ZB[(size_t)(MP + 16 * F.wave + 4 * fq + reg) * AP + n0 + fr] = (bf16_t)f2bf(acc[reg]);
        }
        pg8::Gemm g{MIX, Wout_t, MP, DM, DM, AP, AP}; pg8::StaticOrder S; S.init(MP, DM, F.G, (int)blockIdx.x, 1 + ((REPEAT_MASK >> 4) & 1)); RSYNC(S, 4);
        if (PROBE_P4 == 1) { S.sub_n = 4; S.sub_o = 0; } if (PROBE_P4 == 2) { S.sub_n = 4; S.sub_o = 0; g.A2 = XN; }
        pg8::EpiBf16 E{ZB, AP};
        pg8::gemm_phase<pg8::EpiBf16, pg8::StaticOrder>(ring, xlds, g, S, E);
    }
    GRID_BAR(4);

    if (IN(5)) for (int rep_ = 0; rep_ <= ((REPEAT_MASK >> 5) & 1); ++rep_) {
        const float* gpost = F.in[14]; const float* gpre2 = F.in[15];
        for (int m0 = gw; m0 < MP + MS; m0 += 4 * NGW) {
            u32x2 xw[4][4], zw[4][4];
#pragma unroll
            for (int r = 0; r < 4; ++r) { const int m_ = m0 + r * NGW, m = m_ < MP + MS ? m_ : m0; const u32x2* xr = (const u32x2*)(XN + (size_t)m * AP) + F.lane; const u32x2* zr = (const u32x2*)(ZB + (size_t)m * AP) + F.lane;
#pragma unroll
                for (int j = 0; j < 4; ++j) { xw[r][j] = xr[64 * j]; zw[r][j] = zr[64 * j]; } }
            __builtin_amdgcn_sched_barrier(0);
#pragma unroll
            for (int r = 0; r < 4; ++r) { const int m = m0 + r * NGW; if (m >= MP + MS) break;
                f32x4 z[4], x[4]; float s = 0.f;
#pragma unroll
                for (int j = 0; j < 4; ++j) { const u32x2 w = zw[r][j]; z[j] = (f32x4){bf_lo(w.x), bf_hi(w.x), bf_lo(w.y), bf_hi(w.y)}; s += (z[j].x * z[j].x + z[j].y * z[j].y) + (z[j].z * z[j].z + z[j].w * z[j].w); }
                const float rz = 1.0f / sqrtf(wave_sum(s) * (1.f / DM) + EPS); float s1 = 0.f;
#pragma unroll
                for (int j = 0; j < 4; ++j) { const u32x2 w = xw[r][j]; const f32x4 gg = ((const f32x4*)gpost)[F.lane + 64 * j]; x[j] = (f32x4){bf_lo(w.x), bf_hi(w.x), bf_lo(w.y), bf_hi(w.y)} + z[j] * rz * gg;
                    s1 += (x[j].x * x[j].x + x[j].y * x[j].y) + (x[j].z * x[j].z + x[j].w * x[j].w); }
                const float r1 = 1.0f / sqrtf(wave_sum(s1) * (1.f / DM) + EPS);
                if (F.lane == 0) RSTD1[m] = r1;
                unsigned long long* yo = (unsigned long long*)(X1B + (size_t)m * AP) + F.lane;
#pragma unroll
                for (int j = 0; j < 4; ++j) yo[64 * j] = (unsigned long long)pk2(x[j].x, x[j].y) | ((unsigned long long)pk2(x[j].z, x[j].w) << 32); }
        }
    }
    GRID_BAR(5);

    if (IN(6)) {
        const float* cw = F.in[17]; const float* cb = F.in[18]; const float* stc = F.in[6];
        for (int rs_ = 0; rs_ <= PROBE_SMP; ++rs_) for (int s = F.vcu; s < FF / 16; s += F.G) {
            const int c0 = 16 * s, nu = 256 * (c0 >> 7) + (c0 & 127), fr = F.lane & 15, fq = F.lane >> 4, b = F.wave, col = c0 + fr;
            f32x4 au = skinny(X1B + (size_t)MP * AP, AP, Wup_t, AP, nu, F.wave, F.lane, DM, ring), av = skinny(X1B + (size_t)MP * AP, AP, Wup_t, AP, nu + 128, F.wave, F.lane, DM, ring);
#pragma unroll
            for (int reg = 0; reg < 4; ++reg) { const float rs = RSTD1[MP + 16 * b + 4 * fq + reg]; au[reg] *= rs; av[reg] *= rs; }
            const float up3 = __shfl_up(au[3], 16), up2 = __shfl_up(au[2], 16);
            const float sc0 = stc[((size_t)b * 2 + 0) * FF + col], sc1 = stc[((size_t)b * 2 + 1) * FF + col];
            const float m1 = (fq == 0) ? sc1 : up3, m2 = (fq == 0) ? sc0 : up2;
            const float w0 = cw[col], w1 = cw[FF + col], w2 = cw[2 * FF + col], bz = cb[col];
            float uu[6] = {m2, m1, au[0], au[1], au[2], au[3]};
#pragma unroll
            for (int reg = 0; reg < 4; ++reg) { const float cv = bz + w0 * uu[reg] + w1 * uu[reg + 1] + w2 * uu[reg + 2];
                GT[(size_t)(MP + 16 * b + 4 * fq + reg) * GTP + col] = (bf16_t)f2bf(gelu1(cv) * av[reg]); }
            if (fq == 3) { F.out[O_CVS + ((size_t)b * 2 + 0) * FF + col] = au[2]; F.out[O_CVS + ((size_t)b * 2 + 1) * FF + col] = au[3]; }
        }
        pg8::Gemm g{X1B, Wup_t, MP, NUP, DM, AP, AP}; pg8::StaticOrder S; S.init(MP, NUP, F.G, (int)blockIdx.x, 1 + ((REPEAT_MASK >> 6) & 1)); RSYNC(S, 6);
        pg8::EpiUp E{GT, cw, cb, uhalo, fixu, fixv, F.out, RSTD1};
        pg8::gemm_phase<pg8::EpiUp, pg8::StaticOrder>(ring, xlds, g, S, E);
    }
    GRID_BAR(6);

    if (IN(7)) {
        const float* cw = F.in[17]; const float* cb = F.in[18];
        pg8::StaticOrder S; S.init(MP, DM, F.G, (int)blockIdx.x, 1 + ((REPEAT_MASK >> 7) & 1)); RSYNC(S, 7);
        { pg8::Unit u;
          for (int i = 0; S.next(i, u); ++i) {
              const int pm = u.pm; if ((pm & 15) == 0) continue;
              for (int e = F.tid; e < 2 * FF; e += 512) { const int j = e / FF, c = e % FF;
                  const float hm2 = uhalo[((size_t)(pm - 1) * 2 + 0) * FF + c], hm1 = uhalo[((size_t)(pm - 1) * 2 + 1) * FF + c];
                  const float u0 = fixu[((size_t)pm * 2 + 0) * FF + c], u1 = fixu[((size_t)pm * 2 + 1) * FF + c], vv = fixv[((size_t)pm * 2 + j) * FF + c];
                  const float p2 = j == 0 ? hm2 : hm1, p1 = j == 0 ? hm1 : u0, cur = j == 0 ? u0 : u1;
                  const float cv = cb[c] + cw[c] * p2 + cw[FF + c] * p1 + cw[2 * FF + c] * cur;
                  GT[(size_t)(pm * 256 + j) * GTP + c] = (bf16_t)f2bf(gelu1(cv) * vv); }
          }
          VM_WAIT(); __syncthreads(); }
        for (int rs_ = 0; rs_ <= PROBE_SMP; ++rs_) for (int s = F.vcu; s < DM / 16; s += F.G) {
            const int n0 = 16 * s; const f32x4 acc = skinny(GT + (size_t)MP * GTP, GTP, Wd_t, GTP, n0, F.wave, F.lane, FF, ring);
            const int fr = F.lane & 15, fq = F.lane >> 4;
#pragma unroll
            for (int reg = 0; reg < 4; ++reg) FB[(size_t)(MP + 16 * F.wave + 4 * fq + reg) * AP + n0 + fr] = (bf16_t)f2bf(acc[reg]);
        }
        pg8::Gemm g{GT, Wd_t, MP, DM, FF, GTP, GTP};
        pg8::EpiBf16 E{FB, AP};
        pg8::gemm_phase<pg8::EpiBf16, pg8::StaticOrder>(ring, xlds, g, S, E);
    }
    GRID_BAR(7);

    if (IN(8)) for (int rep_ = 0; rep_ <= ((REPEAT_MASK >> 8) & 1); ++rep_) {
        const float* gp = F.in[20];
        for (int m0 = gw; m0 < MP + MS; m0 += 4 * NGW) {
            u32x2 xw[4][4], fw[4][4];
#pragma unroll
            for (int r = 0; r < 4; ++r) { const int m_ = m0 + r * NGW, m = m_ < MP + MS ? m_ : m0; const u32x2* fr_ = (const u32x2*)(FB + (size_t)m * AP) + F.lane; const u32x2* xr_ = (const u32x2*)(X1B + (size_t)m * AP) + F.lane;
#pragma unroll
                for (int j = 0; j < 4; ++j) { xw[r][j] = xr_[64 * j]; fw[r][j] = fr_[64 * j]; } }
            __builtin_amdgcn_sched_barrier(0);
#pragma unroll
            for (int r = 0; r < 4; ++r) { const int m = m0 + r * NGW; if (m >= MP + MS) break;
                f32x4 z[4]; float s = 0.f;
#pragma unroll
                for (int j = 0; j < 4; ++j) { const u32x2 w = fw[r][j]; z[j] = (f32x4){bf_lo(w.x), bf_hi(w.x), bf_lo(w.y), bf_hi(w.y)}; s += (z[j].x * z[j].x + z[j].y * z[j].y) + (z[j].z * z[j].z + z[j].w * z[j].w); }
                const float rz = 1.0f / sqrtf(wave_sum(s) * (1.f / DM) + EPS);
                f32x4* yr = (f32x4*)yrow_ptr(F, m) + F.lane;
#pragma unroll
                for (int j = 0; j < 4; ++j) { const u32x2 w = xw[r][j]; const f32x4 x = (f32x4){bf_lo(w.x), bf_hi(w.x), bf_lo(w.y), bf_hi(w.y)}; const f32x4 gg = ((const f32x4*)gp)[F.lane + 64 * j]; yr[64 * j] = x + z[j] * rz * gg; } }
        }
    }
    if (one_launch) for (int xb_ = 0; xb_ < PROBE_XBAR; ++xb_) xcd_barrier(bar);
#undef IN
#undef GRID_BAR
}

#ifndef MK_PER_PHASE
#define MK_PER_PHASE 0
#endif
extern "C" void kernel_launch(void* const* d_in, const int* in_sizes, int n_in, void* d_out, int out_size, void* d_ws, size_t ws_size, hipStream_t stream) {
    static int grid = 0;
    if (grid == 0) {
        if (n_in != 21 || (size_t)out_size != O_END || ws_size < WS_END) { fprintf(stderr, "kernel_launch: unexpected shapes n_in %d out %d ws %zu\n", n_in, out_size, ws_size); grid = -1; return; }
        int dev = 0, cus = 0;
        if (hipGetDevice(&dev) != hipSuccess || hipDeviceGetAttribute(&cus, hipDeviceAttributeMultiprocessorCount, dev) != hipSuccess) { grid = -1; return; }
        if (hipFuncSetAttribute((const void*)fwd_kernel, hipFuncAttributeMaxDynamicSharedMemorySize, LDS_BYTES) != hipSuccess) { fprintf(stderr, "kernel_launch: hipFuncSetAttribute failed\n"); grid = -1; return; }
        (void)hipGetLastError();
        grid = cus;
    }
    if (grid < 0) return;
    (void)hipMemsetAsync((char*)d_ws + WS_CTL, 0, CTL_ZERO_BYTES, stream);
    Args a{};
    for (int i = 0; i < 21; ++i) a.in[i] = (const float*)d_in[i];
    a.out = (float*)d_out; a.ws = (unsigned char*)d_ws;
#if MK_PER_PHASE
    for (int p = 0; p < 9; ++p) { a.ph_lo = p; a.ph_hi = p + 1; hipLaunchKernelGGL(fwd_kernel, dim3(grid), dim3(512), LDS_BYTES, stream, a); }
#else
    a.ph_lo = 0; a.ph_hi = 9;
    hipLaunchKernelGGL(fwd_kernel, dim3(grid), dim3(512), LDS_BYTES, stream, a);
#endif
}
```

```cpp
#include <hip/hip_runtime.h>
#include <cstdio>
#include <cstdint>
#include <cmath>

#ifndef REPEAT_MASK
#define REPEAT_MASK 0
#endif
#ifndef PROBE_SUB_N
#define PROBE_SUB_N 0
#define PROBE_SUB_O 0
#endif
#ifndef PROBE_P4
#define PROBE_P4 0
#endif
#ifndef PROBE_SMP
#define PROBE_SMP 0
#endif
#ifndef PROBE_XBAR
#define PROBE_XBAR 0
#endif
#ifndef PROBE_NOEPI
#define PROBE_NOEPI 0
#endif
#ifndef ROUND_SYNC
#define ROUND_SYNC 0
#endif
#ifndef REPEAT_ATT
#define REPEAT_ATT 0
#endif
#define LAS __attribute__((address_space(3)))
#define GAS __attribute__((address_space(1)))
typedef unsigned short bf16_t;
typedef short bf16x8 __attribute__((ext_vector_type(8)));
typedef short s16x4 __attribute__((ext_vector_type(4)));
typedef float f32x2 __attribute__((ext_vector_type(2)));
typedef float f32x4 __attribute__((ext_vector_type(4)));
typedef float f32x16 __attribute__((ext_vector_type(16)));
typedef unsigned u32x2 __attribute__((ext_vector_type(2)));
typedef unsigned u32x4 __attribute__((ext_vector_type(4)));

constexpr int DM = 1024, NBATCH = 16, SEQ = 4096, MP = NBATCH * SEQ;
constexpr int SB = 8, ST = 16, MS = SB * ST, PAST = 1024;
constexpr int MROWS = MP + 256;
constexpr int FF = 2816, NIN = 4352, NUP = 2 * FF;
constexpr int GTP = 2880;
constexpr int SKVR = 576, SKVP = 1280;
constexpr int QKVP = 2304, GP = 2176;
constexpr size_t H_QA = 0, H_KA = H_QA + (size_t)MP * 512, H_VA = H_KA + (size_t)MP * 128, H_QB = H_VA + (size_t)MP * 128, H_KB = H_QB + (size_t)MP * 512, H_VB = H_KB + (size_t)MP * 512;
__host__ __device__ __forceinline__ size_t hm_off(int nheads, int b, int head, int t) { return (((size_t)b * nheads + head) * SEQ + t) * 64; }
constexpr int SQP = 1024;
constexpr int AP = 1088;
constexpr float EPS = 1e-6f;
constexpr float LOG2E = 1.4426950408889634f;
constexpr float C2 = 0.125f * LOG2E;

constexpr size_t O_YP = 0, O_YS = O_YP + (size_t)MP * DM, O_AKP = O_YS + (size_t)MS * DM, O_AVP = O_AKP + 16 * 128 * 128, O_BKP = O_AVP + 16 * 128 * 128,
                 O_BVP = O_BKP + (size_t)16 * 512 * 512, O_CVP = O_BVP + (size_t)16 * 512 * 512, O_AKS = O_CVP + 16 * 2 * FF, O_AVS = O_AKS + 8 * 16 * 128,
                 O_BKS = O_AVS + 8 * 16 * 128, O_BVS = O_BKS + 8 * 16 * 512, O_CVS = O_BVS + 8 * 16 * 512, O_END = O_CVS + 8 * 2 * FF;

constexpr size_t MiB = 1u << 20;
constexpr size_t WS_CTL = 0, CTL_ZERO_BYTES = 1 * MiB;
constexpr size_t WS_CS = 1 * MiB;
constexpr size_t WS_WIN = 2 * MiB, WS_WOAB = 12 * MiB, WS_WOUT = 15 * MiB, WS_WUP = 18 * MiB, WS_WD = 30 * MiB;
constexpr size_t WS_UHALO = 36 * MiB, WS_FIXU = 42 * MiB, WS_FIXV = 48 * MiB;
constexpr size_t WS_S1 = 54 * MiB;
constexpr size_t WS_SQ = 56 * MiB + 512 * 1024;
constexpr size_t WS_RSTD0 = 56 * MiB + 768 * 1024, WS_RSTD1 = 57 * MiB + 256 * 1024;
constexpr size_t WS_SKV = 58 * MiB;
constexpr size_t WS_XN = 70 * MiB;
constexpr size_t WS_QKV = 207 * MiB;
constexpr size_t WS_G = 497 * MiB;
constexpr size_t WS_O = 771 * MiB;
constexpr size_t WS_END = 908 * MiB;
constexpr size_t WS_X1B = 600 * MiB;
static_assert(WS_X1B >= WS_QKV + (size_t)MROWS * GTP * 2 && WS_X1B + (size_t)MROWS * AP * 2 <= WS_O && WS_X1B >= WS_G, "x1 buffer");
static_assert(WS_SKV + (size_t)SB * SKVR * SKVP * 2 <= WS_XN && WS_S1 + (size_t)MS * NIN * 4 <= WS_SQ && WS_SQ + (size_t)MS * SQP * 2 <= WS_RSTD0 && WS_RSTD0 + (size_t)MROWS * 4 <= WS_RSTD1 && WS_RSTD1 + (size_t)MROWS * 4 <= WS_SKV, "ws map small");
static_assert(WS_XN + (size_t)MROWS * AP * 2 <= WS_QKV && WS_QKV + (size_t)MROWS * QKVP * 2 <= WS_G && WS_G + (size_t)MROWS * GP * 2 <= WS_O && WS_O + (size_t)MROWS * AP * 2 <= WS_END, "ws map");
static_assert(WS_WIN + (size_t)NIN * AP * 2 <= WS_WOAB && WS_WOAB + (size_t)DM * AP * 2 <= WS_WOUT && WS_WOUT + (size_t)DM * AP * 2 <= WS_WUP && WS_WUP + (size_t)NUP * AP * 2 <= WS_WD && WS_WD + (size_t)DM * FF * 2 <= WS_UHALO, "ws weights");
static_assert(WS_QKV + (size_t)MROWS * GTP * 2 <= WS_O && WS_WD + (size_t)DM * GTP * 2 <= WS_UHALO, "gated overlay");
constexpr int CW_TMO = 0, CW_BAR = 4096, CW_ROUND = 16384;

constexpr int RING_BYTES = 131072;
constexpr int XLDS_OFF = RING_BYTES;
constexpr int MISC_OFF = RING_BYTES + 8192;
constexpr int LDS_BYTES = 147456;

#define RLX_AGENT __ATOMIC_RELAXED, __HIP_MEMORY_SCOPE_AGENT
__device__ __forceinline__ unsigned cvt_pk_bf16(float lo, float hi) { unsigned r; asm volatile("v_cvt_pk_bf16_f32 %0, %1, %2" : "=v"(r) : "v"(lo), "v"(hi)); return r; }
__device__ __forceinline__ unsigned f2bf(float f) { unsigned u = __builtin_bit_cast(unsigned, f); return (u + 0x7fffu + ((u >> 16) & 1u)) >> 16; }
__device__ __forceinline__ unsigned pk2(float lo, float hi) { return f2bf(lo) | (f2bf(hi) << 16); }
__device__ __forceinline__ float bf_lo(unsigned w) { return __builtin_bit_cast(float, w << 16); }
__device__ __forceinline__ float bf_hi(unsigned w) { return __builtin_bit_cast(float, w & 0xffff0000u); }
__device__ __forceinline__ float wave_sum(float v) {
#pragma unroll
    for (int o = 1; o < 64; o <<= 1) v += __shfl_xor(v, o);
    return v;
}
__device__ __forceinline__ float wave_max(float v) {
#pragma unroll
    for (int o = 1; o < 64; o <<= 1) v = fmaxf(v, __shfl_xor(v, o));
    return v;
}
__device__ __forceinline__ f32x2 gelu_pk(f32x2 v) {
    const f32x2 av = __builtin_elementwise_abs(v), d = av * 0.2316418882f + 1.0f;
    f32x2 t; t.x = __builtin_amdgcn_rcpf(d.x); t.y = __builtin_amdgcn_rcpf(d.y);
    f32x2 q = t * 0.5307027145f + (-0.7265760135f); q = q * t + 0.7107068705f; q = q * t + (-0.142248368f); q = q * t + 0.127414796f; q = q * t;
    const f32x2 s = (v * v) * (-0.72134752044f);
    f32x2 e; e.x = __builtin_amdgcn_exp2f(s.x); e.y = __builtin_amdgcn_exp2f(s.y);
    const f32x2 m = v * (q * e), r = v - m;
    f32x2 o; o.x = v.x < 0.f ? m.x : r.x; o.y = v.y < 0.f ? m.y : r.y; return o;
}
__device__ __forceinline__ float gelu1(float v) { f32x2 r = gelu_pk((f32x2){v, v}); return r.x; }
__device__ __forceinline__ float sigmoidf_(float g) { g = fminf(fmaxf(g, -30.f), 30.f); return 1.0f / (1.0f + __expf(-g)); }

__host__ __device__ __forceinline__ int rope_j(int d) { return d < 32 ? 8 * (d >> 2) + (d & 3) : 8 * ((d - 32) >> 2) + 4 + ((d - 32) & 3); }
__host__ __device__ __forceinline__ int rope_d(int j) { const int q = j >> 3, e = j & 7; return e < 4 ? 4 * q + e : 32 + 4 * q + (e - 4); }
__host__ __device__ __forceinline__ int gcol_in(int n) {
    if (n < 640) return (n & ~63) + rope_j(n & 63);
    if (n < 2304) return n;
    if (n < 3328) { const int c = n - 2304; return 2304 + 256 * (c >> 7) + (c & 127); }
    const int c = n - 3328; return 2304 + 256 * (c >> 7) + 128 + (c & 127);
}
__host__ __device__ __forceinline__ int src_in(int g) {
    if (g < 640) return (g & ~63) + rope_d(g & 63);
    if (g < 2304) return g;
    const int c = g - 2304, p = c >> 8, w = c & 255; return w < 128 ? 2304 + 128 * p + w : 3328 + 128 * p + (w - 128);
}
__host__ __device__ __forceinline__ int gcol_up(int n) { if (n < FF) return 256 * (n >> 7) + (n & 127); const int c = n - FF; return 256 * (c >> 7) + 128 + (c & 127); }

namespace pg8 {
constexpr int BM = 256, BK = 64, HALF = 128, HTB = HALF * BK * 2, STAGE_BYTES = 8 * HTB, NXCD = 8, WGM = 8;
__host__ __device__ __forceinline__ int lds_byte(int r, int c) { const int st = (r >> 4) * 2 + (c >> 5), rr = r & 15, cc = c & 31, ob = rr * 64 + cc * 2; return st * 1024 + (ob ^ (((ob >> 9) & 1) << 5)); }
__host__ __device__ __forceinline__ void stage_rc(int b, int& R, int& C) { const int st = b / 1024, sb = b % 1024, swz = sb ^ (((sb >> 9) & 1) << 5); R = (st >> 1) * 16 + swz / 64; C = (st & 1) * 32 + (swz % 64) / 2; }
__host__ __device__ __forceinline__ int perm32(int rho) { const int n = rho >> 4, i = rho & 15; return 8 * (i >> 2) + 4 * n + (i & 3); }
struct Unit { int pm, pn; };
struct Gemm { const bf16_t* A; const bf16_t* Bt; int M, N, K, lda, ldb; const bf16_t* A2 = nullptr; };
struct StaticOrder {
    int nM, nN, nwg, G, c, rep, sub_n = 0, sub_o = 0;
    unsigned* rcnt = nullptr; unsigned nloc = 0;
    __host__ __device__ void init(int M, int N, int G_, int c_, int rep_ = 1) { nM = M / BM; nN = N / BM; nwg = nM * nN; G = G_; c = c_; rep = rep_; }
    __host__ __device__ bool next(int i, Unit& u) const {
        if (rep > 1) { const int rounds = (nwg + G - 1) / G; if (i >= rep * rounds) return false; i = i % rounds; }
        if (sub_n > 0) { const int rounds = (nwg + G - 1) / G;
            if (i >= rounds) { const int i2 = i - rounds, nw2 = nM * sub_n; const long L2 = (long)i2 * G + c; if (L2 >= nw2) return false;
                int w2 = (int)L2; { const int q = nw2 / NXCD, xcd = w2 % NXCD, off = w2 / NXCD; w2 = xcd * q + off; }
                const int nig2 = WGM * sub_n; u.pm = (w2 / nig2) * WGM + ((w2 % nig2) % WGM); u.pn = sub_o + (w2 % nig2) / WGM; return true; } }
        const long L = (long)i * G + c; if (L >= nwg) return false;
        int wgid = (int)L; { const int q = nwg / NXCD, r = nwg % NXCD, xcd = wgid % NXCD, off = wgid / NXCD; wgid = (xcd < r ? xcd * (q + 1) : r * (q + 1) + (xcd - r) * q) + off; }
        const int nig = WGM * nN, gid = wgid / nig, fm = gid * WGM, gsz = (nM - fm) < WGM ? (nM - fm) : WGM;
        u.pm = fm + ((wgid % nig) % gsz); u.pn = (wgid % nig) / gsz; return true;
    }
};

typedef f32x4 Acc[2][2][4][2];

struct EpiBf16 {
    static constexpr bool HAS_MID = false; static constexpr int MID_T = 0;
    bf16_t* O; int ldc;
    __device__ __forceinline__ void mid(Acc&, const Unit&, int, int, int, int) const {}
    __device__ __forceinline__ void operator()(Acc& acc, const Unit& u, int wr, int wc, int fr, int fq, LAS unsigned char*) const {
        asm volatile("" : "+v"(fr), "+v"(fq));
        const int row0 = u.pm * BM + wr * 64 + fr, col0 = u.pn * BM + wc * 32 + 8 * fq;
#pragma unroll
        for (int ai = 0; ai < 2; ++ai)
#pragma unroll
            for (int m = 0; m < 4; ++m) { bf16_t* rowp = O + (size_t)(row0 + ai * HALF + m * 16) * ldc + col0;
#pragma unroll
                for (int bj = 0; bj < 2; ++bj) { const f32x4 v0 = acc[ai][bj][m][0], v1 = acc[ai][bj][m][1];
                    u32x4 w; w.x = cvt_pk_bf16(v0[0], v0[1]); w.y = cvt_pk_bf16(v0[2], v0[3]); w.z = cvt_pk_bf16(v1[0], v1[1]); w.w = cvt_pk_bf16(v1[2], v1[3]);
                    *(u32x4*)(rowp + bj * HALF) = w; } }
    }
};

struct EpiIn {
    static constexpr bool HAS_MID = false; static constexpr int MID_T = 0;
    bf16_t* QKV; bf16_t* G; const float* CS; float* out; const float* rstd;
    __device__ __forceinline__ void mid(Acc&, const Unit&, int, int, int, int) const {}
    __device__ __forceinline__ void operator()(Acc& acc, const Unit& u, int wr, int wc, int fr, int fq, LAS unsigned char*) const {
        asm volatile("" : "+v"(fr), "+v"(fq));
        { float rs[2][4];
#pragma unroll
          for (int ai = 0; ai < 2; ++ai)
#pragma unroll
              for (int m = 0; m < 4; ++m) rs[ai][m] = rstd[u.pm * BM + ai * HALF + wr * 64 + m * 16 + fr];
#pragma unroll
          for (int ai = 0; ai < 2; ++ai)
#pragma unroll
              for (int bj = 0; bj < 2; ++bj)
#pragma unroll
                  for (int m = 0; m < 4; ++m) { acc[ai][bj][m][0] *= rs[ai][m]; acc[ai][bj][m][1] *= rs[ai][m]; } }
        const int pn = u.pn, pm = u.pm;
        const int row0 = pm * BM + wr * 64 + fr, cl = wc * 32 + 8 * fq;
        const int bb = pm >> 4, tail = pm & 15;
        if (pn <= 2) {
            const float sc = (pn < 2) ? C2 : 1.0f;
            const int dd0 = 16 * (wc & 1) + 4 * fq, g = wc >> 1;
            f32x4 csv[2][4], snv[2][4];
#pragma unroll
            for (int ai = 0; ai < 2; ++ai)
#pragma unroll
                for (int m = 0; m < 4; ++m) { const int t = (row0 + ai * HALF + m * 16) & (SEQ - 1); csv[ai][m] = *(const f32x4*)(CS + (size_t)t * 64 + dd0); snv[ai][m] = *(const f32x4*)(CS + (size_t)t * 64 + 32 + dd0); }
            __builtin_amdgcn_sched_barrier(0);
#pragma unroll
            for (int ai = 0; ai < 2; ++ai)
#pragma unroll
                for (int m = 0; m < 4; ++m) {
                    const int row = row0 + ai * HALF + m * 16, t = row & (SEQ - 1);
                    const f32x4 cs = csv[ai][m], sn = snv[ai][m];
#pragma unroll
                    for (int bj = 0; bj < 2; ++bj) {
                        const f32x4 x1 = acc[ai][bj][m][0], x2 = acc[ai][bj][m][1];
                        bf16_t* dst = (pn < 2) ? QKV + H_QA + hm_off(8, bb, 4 * pn + 2 * bj + g, t) + 32 * (wc & 1) + 8 * fq
                                               : QKV + (bj == 0 ? H_KA : H_VA) + hm_off(2, bb, g, t) + 32 * (wc & 1) + 8 * fq;
                        if (pn == 2 && bj == 1) {
                            u32x4 w; w.x = cvt_pk_bf16(x1[0], x1[1]); w.y = cvt_pk_bf16(x1[2], x1[3]); w.z = cvt_pk_bf16(x2[0], x2[1]); w.w = cvt_pk_bf16(x2[2], x2[3]);
                            *(u32x4*)dst = w;
                            if (tail == 15 && ai == 1) { float* o = out + O_AVP + ((size_t)(bb * 128 + (t - (SEQ - 128))) * 2 + g) * 64 + 32 * (wc & 1) + 8 * fq; *(f32x4*)o = x1; *(f32x4*)(o + 4) = x2; }
                        } else {
                            const f32x4 o1 = (x1 * cs - x2 * sn) * sc, o2 = (x2 * cs + x1 * sn) * sc;
                            u32x4 w; w.x = cvt_pk_bf16(o1[0], o1[1]); w.y = cvt_pk_bf16(o1[2], o1[3]); w.z = cvt_pk_bf16(o2[0], o2[1]); w.w = cvt_pk_bf16(o2[2], o2[3]);
                            *(u32x4*)dst = w;
                            if (pn == 2 && tail == 15 && ai == 1) { float* o = out + O_AKP + ((size_t)(bb * 128 + (t - (SEQ - 128))) * 2 + g) * 64 + dd0; *(f32x4*)o = o1; *(f32x4*)(o + 32) = o2; }
                        }
                    }
                }
        } else if (pn <= 8) {
            const float sc = (pn <= 4) ? C2 : 1.0f;
            float* cout = nullptr; int ccol = 0;
            if (pn >= 5 && tail >= 14) { cout = out + ((pn <= 6) ? O_BKP : O_BVP); ccol = ((pn - 5) & 1) * BM + cl; }
#pragma unroll
            for (int ai = 0; ai < 2; ++ai)
#pragma unroll
                for (int m = 0; m < 4; ++m) {
                    const int row = row0 + ai * HALF + m * 16, t = row & (SEQ - 1);
#pragma unroll
                    for (int bj = 0; bj < 2; ++bj) {
                        const f32x4 v0 = acc[ai][bj][m][0] * sc, v1 = acc[ai][bj][m][1] * sc;
                        u32x4 w; w.x = cvt_pk_bf16(v0[0], v0[1]); w.y = cvt_pk_bf16(v0[2], v0[3]); w.z = cvt_pk_bf16(v1[0], v1[1]); w.w = cvt_pk_bf16(v1[2], v1[3]);
                        { const size_t tb = (pn <= 4) ? H_QB : ((pn <= 6) ? H_KB : H_VB); const int hd = 4 * ((pn - 3) & 1) + 2 * bj + (wc >> 1);
                          *(u32x4*)(QKV + tb + hm_off(8, bb, hd, t) + 32 * (wc & 1) + 8 * fq) = w; }
                        if (cout) { float* o = cout + ((size_t)(bb * 512 + (t - (SEQ - 512)))) * 512 + ccol + bj * HALF; *(f32x4*)o = v0; *(f32x4*)(o + 4) = v1; }
                    }
                }
        } else {
            const int c0 = 128 * (pn - 9) + cl;
#pragma unroll
            for (int ai = 0; ai < 2; ++ai)
#pragma unroll
                for (int m = 0; m < 4; ++m) {
                    const int row = row0 + ai * HALF + m * 16;
                    float rt[8], sg[8];
#pragma unroll
                    for (int n = 0; n < 2; ++n)
#pragma unroll
                        for (int i = 0; i < 4; ++i) {
                            const float ga = fminf(fmaxf(acc[ai][0][m][n][i], -30.f), 30.f), gb = fminf(fmaxf(acc[ai][1][m][n][i], -30.f), 30.f);
                            const float ea = __expf(-ga), eb = __expf(-gb);
                            sg[4 * n + i] = __builtin_amdgcn_rcpf(1.0f + eb); rt[4 * n + i] = (1.0f + eb) * __builtin_amdgcn_rcpf(1.0f + ea);
                        }
                    u32x4 w; w.x = cvt_pk_bf16(rt[0], rt[1]); w.y = cvt_pk_bf16(rt[2], rt[3]); w.z = cvt_pk_bf16(rt[4], rt[5]); w.w = cvt_pk_bf16(rt[6], rt[7]);
                    *(u32x4*)(G + (size_t)row * GP + c0) = w;
                    w.x = cvt_pk_bf16(sg[0], sg[1]); w.y = cvt_pk_bf16(sg[2], sg[3]); w.z = cvt_pk_bf16(sg[4], sg[5]); w.w = cvt_pk_bf16(sg[6], sg[7]);
                    *(u32x4*)(G + (size_t)row * GP + 1024 + c0) = w;
                }
        }
    }
};

struct EpiGate {
    static constexpr bool HAS_MID = true; static constexpr int MID_T = 8;
    const bf16_t* G; bf16_t* O;
    __device__ __forceinline__ void mid(Acc& acc, const Unit& u, int wr, int wc, int fr, int fq) const {
        asm volatile("" : "+v"(fr), "+v"(fq));
        const int row0 = u.pm * BM + wr * 64 + fr, col0 = u.pn * BM + wc * 32 + 8 * fq;
        u32x4 g[2][4][2];
#pragma unroll
        for (int ai = 0; ai < 2; ++ai)
#pragma unroll
            for (int m = 0; m < 4; ++m)
#pragma unroll
                for (int bj = 0; bj < 2; ++bj) g[ai][m][bj] = *(const u32x4*)(G + (size_t)(row0 + ai * HALF + m * 16) * GP + col0 + bj * HALF);
        __builtin_amdgcn_sched_barrier(0);
#pragma unroll
        for (int ai = 0; ai < 2; ++ai)
#pragma unroll
            for (int m = 0; m < 4; ++m)
#pragma unroll
                for (int bj = 0; bj < 2; ++bj) { const u32x4 w = g[ai][m][bj];
                    acc[ai][bj][m][0] *= (f32x4){bf_lo(w.x), bf_hi(w.x), bf_lo(w.y), bf_hi(w.y)}; acc[ai][bj][m][1] *= (f32x4){bf_lo(w.z), bf_hi(w.z), bf_lo(w.w), bf_hi(w.w)}; }
    }
    __device__ __forceinline__ void operator()(Acc& acc, const Unit& u, int wr, int wc, int fr, int fq, LAS unsigned char*) const {
        asm volatile("" : "+v"(fr), "+v"(fq));
        const int row0 = u.pm * BM + wr * 64 + fr, col0 = u.pn * BM + wc * 32 + 8 * fq;
        u32x4 g[2][4][2];
#pragma unroll
        for (int ai = 0; ai < 2; ++ai)
#pragma unroll
            for (int m = 0; m < 4; ++m)
#pragma unroll
                for (int bj = 0; bj < 2; ++bj) g[ai][m][bj] = *(const u32x4*)(G + (size_t)(row0 + ai * HALF + m * 16) * GP + 1024 + col0 + bj * HALF);
        __builtin_amdgcn_sched_barrier(0);
#pragma unroll
        for (int ai = 0; ai < 2; ++ai)
#pragma unroll
            for (int m = 0; m < 4; ++m) { const size_t row = (size_t)(row0 + ai * HALF + m * 16);
#pragma unroll
                for (int bj = 0; bj < 2; ++bj) { const u32x4 gg = g[ai][m][bj];
                    const f32x4 v0 = acc[ai][bj][m][0] * (f32x4){bf_lo(gg.x), bf_hi(gg.x), bf_lo(gg.y), bf_hi(gg.y)}, v1 = acc[ai][bj][m][1] * (f32x4){bf_lo(gg.z), bf_hi(gg.z), bf_lo(gg.w), bf_hi(gg.w)};
                    u32x4 w; w.x = cvt_pk_bf16(v0[0], v0[1]); w.y = cvt_pk_bf16(v0[2], v0[3]); w.z = cvt_pk_bf16(v1[0], v1[1]); w.w = cvt_pk_bf16(v1[2], v1[3]);
                    *(u32x4*)(O + row * AP + col0 + bj * HALF) = w; } }
    }
};

__device__ __forceinline__ float dpp_ror1(float v) { return __builtin_bit_cast(float, __builtin_amdgcn_update_dpp(0, __builtin_bit_cast(int, v), 0x121, 0xf, 0xf, true)); }
__device__ __forceinline__ float dpp_ror2(float v) { return __builtin_bit_cast(float, __builtin_amdgcn_update_dpp(0, __builtin_bit_cast(int, v), 0x122, 0xf, 0xf, true)); }

struct EpiUp {
    static constexpr bool HAS_MID = false; static constexpr int MID_T = 0;
    bf16_t* GT; const float* cw; const float* cb; float* uhalo; float* fixu; float* fixv; float* out; const float* rstd;
    __device__ __forceinline__ void mid(Acc&, const Unit&, int, int, int, int) const {}
    __device__ __forceinline__ void operator()(Acc& acc, const Unit& u, int wr, int wc, int fr, int fq, LAS unsigned char* xl) const {
        asm volatile("" : "+v"(fr), "+v"(fq));
        f32x4 cwa[2], cwb[2], cwc[2], cwd[2];
        { const int c0_ = u.pn * HALF + wc * 32 + 8 * fq;
#pragma unroll
          for (int n = 0; n < 2; ++n) { cwa[n] = *(const f32x4*)(cw + c0_ + 4 * n); cwb[n] = *(const f32x4*)(cw + FF + c0_ + 4 * n); cwc[n] = *(const f32x4*)(cw + 2 * FF + c0_ + 4 * n); cwd[n] = *(const f32x4*)(cb + c0_ + 4 * n); } }
        { float rs[2][4];
#pragma unroll
          for (int ai = 0; ai < 2; ++ai)
#pragma unroll
              for (int m = 0; m < 4; ++m) rs[ai][m] = rstd[u.pm * BM + ai * HALF + wr * 64 + m * 16 + fr];
          __builtin_amdgcn_sched_barrier(0);
#pragma unroll
          for (int ai = 0; ai < 2; ++ai)
#pragma unroll
              for (int bj = 0; bj < 2; ++bj)
#pragma unroll
                  for (int m = 0; m < 4; ++m) { acc[ai][bj][m][0] *= rs[ai][m]; acc[ai][bj][m][1] *= rs[ai][m]; } }
        const int pm = u.pm, pn = u.pn, cl = wc * 32 + 8 * fq, col0 = pn * HALF + cl;
        LAS float* X = (LAS float*)xl;
        if (fr >= 14) {
#pragma unroll
            for (int ai = 0; ai < 2; ++ai)
#pragma unroll
                for (int n = 0; n < 2; ++n) *(LAS f32x4*)(X + ((ai * 2 + wr) * 2 + (fr - 14)) * 128 + cl + 4 * n) = acc[ai][0][3][n];
            if (wr == 1) {
                float* h = uhalo + ((size_t)pm * 2 + (fr - 14)) * FF + col0; *(f32x4*)h = acc[1][0][3][0]; *(f32x4*)(h + 4) = acc[1][0][3][1];
                if ((pm & 15) == 15) { float* o = out + O_CVP + ((size_t)(pm >> 4) * 2 + (fr - 14)) * FF + col0; *(f32x4*)o = acc[1][0][3][0]; *(f32x4*)(o + 4) = acc[1][0][3][1]; }
            }
        }
        if (wr == 0 && fr < 2) {
            float* a = fixu + ((size_t)pm * 2 + fr) * FF + col0; *(f32x4*)a = acc[0][0][0][0]; *(f32x4*)(a + 4) = acc[0][0][0][1];
            float* b = fixv + ((size_t)pm * 2 + fr) * FF + col0; *(f32x4*)b = acc[0][1][0][0]; *(f32x4*)(b + 4) = acc[0][1][0][1];
        }
        asm volatile("s_waitcnt lgkmcnt(0)" ::: "memory"); __builtin_amdgcn_s_barrier(); asm volatile("" ::: "memory");
        float w0[8], w1[8], w2[8], bz[8];
#pragma unroll
        for (int n = 0; n < 2; ++n) { const f32x4 a = cwa[n], b = cwb[n], c = cwc[n], d = cwd[n];
#pragma unroll
            for (int i = 0; i < 4; ++i) { w0[4 * n + i] = a[i]; w1[4 * n + i] = b[i]; w2[4 * n + i] = c[i]; bz[4 * n + i] = d[i]; } }
#pragma unroll
        for (int ai = 0; ai < 2; ++ai) {
            f32x4 h14[2], h15[2];
            const int src = (wr == 1) ? (ai * 2 + 0) : (0 * 2 + 1);
            const bool has = (wr == 1) || (ai == 1);
#pragma unroll
            for (int n = 0; n < 2; ++n) {
                h14[n] = has ? *(const LAS f32x4*)(X + (src * 2 + 0) * 128 + cl + 4 * n) : (f32x4){0.f, 0.f, 0.f, 0.f};
                h15[n] = has ? *(const LAS f32x4*)(X + (src * 2 + 1) * 128 + cl + 4 * n) : (f32x4){0.f, 0.f, 0.f, 0.f};
            }
#pragma unroll
            for (int m = 0; m < 4; ++m) {
                float gt[8];
#pragma unroll
                for (int n = 0; n < 2; ++n)
#pragma unroll
                    for (int i = 0; i < 4; ++i) {
                        const float cur = acc[ai][0][m][n][i];
                        float p1 = dpp_ror1(cur), p2 = dpp_ror2(cur);
                        if (m > 0) { const float pv = acc[ai][0][m > 0 ? m - 1 : 0][n][i]; const float q1 = dpp_ror1(pv), q2 = dpp_ror2(pv); p1 = (fr == 0) ? q1 : p1; p2 = (fr < 2) ? q2 : p2; }
                        else { p1 = (fr == 0) ? h15[n][i] : p1; p2 = (fr == 0) ? h14[n][i] : ((fr == 1) ? h15[n][i] : p2); }
                        const float cv = bz[4 * n + i] + w0[4 * n + i] * p2 + w1[4 * n + i] * p1 + w2[4 * n + i] * cur;
                        gt[4 * n + i] = cv;
                    }
#pragma unroll
                for (int k = 0; k < 8; k += 2) { const f32x2 r = gelu_pk((f32x2){gt[k], gt[k + 1]}); gt[k] = r.x * acc[ai][1][m][k >> 2][k & 3]; gt[k + 1] = r.y * acc[ai][1][m][(k + 1) >> 2][(k + 1) & 3]; }
                u32x4 w; w.x = cvt_pk_bf16(gt[0], gt[1]); w.y = cvt_pk_bf16(gt[2], gt[3]); w.z = cvt_pk_bf16(gt[4], gt[5]); w.w = cvt_pk_bf16(gt[6], gt[7]);
                *(u32x4*)(GT + (size_t)(pm * BM + ai * HALF + wr * 64 + m * 16 + fr) * GTP + col0) = w;
            }
        }
    }
};

template <class Epi, class Sched>
__device__ __forceinline__ void gemm_phase(LAS unsigned char* lds, LAS unsigned char* xlds, const Gemm g, const Sched& S, const Epi& E) {
    const int tid = threadIdx.x, wid = __builtin_amdgcn_readfirstlane(tid >> 6), lane = tid & 63, wr = wid >> 2, wc = wid & 3, fr = lane & 15, fq = lane >> 4;
    const int K = g.K, nt = K / BK;
    unsigned voffA[2], voffB[2];
#pragma unroll
    for (int i = 0; i < 2; ++i) { int R, C; stage_rc(tid * 16 + i * 8192, R, C); const int Rb = (R & ~31) + perm32(R & 31);
        voffA[i] = (unsigned)(R * g.lda + C) * 2u; voffB[i] = (unsigned)(Rb * g.ldb + C) * 2u; }
    const size_t kstep = (size_t)(BK * 2);
    const size_t hstepA = (size_t)HALF * g.lda * 2, hstepB = (size_t)HALF * g.ldb * 2;
    const size_t tstepA = 2 * hstepA, tstepB = 2 * hstepB;
    const unsigned ldsw = (unsigned)wid * 1024u;
    const int aoff = lds_byte(wr * 64 + fr, fq * 8), boff = lds_byte(wc * 32 + fr, fq * 8);
#define PG8_SA(b, h) (((b) * 2 + (h)) * HTB)
#define PG8_SB(b, h) ((4 + (b) * 2 + (h)) * HTB)
#define PG8_STAGE(bufoff, gbase, voff) do { _Pragma("unroll") for (int _i = 0; _i < 2; ++_i) \
        __builtin_amdgcn_global_load_lds((const unsigned*)((const char*)(gbase) + (voff)[_i]), (LAS unsigned*)(lds + (bufoff) + ldsw + _i * 8192), 16, 0, 0); } while (0)
#define PG8_LDA(dst, b, h) do { _Pragma("unroll") for (int m = 0; m < 4; ++m) _Pragma("unroll") for (int k = 0; k < 2; ++k) dst[m][k] = *(const LAS bf16x8*)(lds + PG8_SA(b, h) + aoff + m * 2048 + k * 1024); } while (0)
#define PG8_LDB(dst, b, h) do { _Pragma("unroll") for (int n = 0; n < 2; ++n) _Pragma("unroll") for (int k = 0; k < 2; ++k) dst[n][k] = *(const LAS bf16x8*)(lds + PG8_SB(b, h) + boff + n * 2048 + k * 1024); } while (0)
#define PG8_MMA(ai, bj, At, Bt) do { __builtin_amdgcn_s_setprio(1); _Pragma("unroll") for (int m = 0; m < 4; ++m) _Pragma("unroll") for (int n = 0; n < 2; ++n) _Pragma("unroll") for (int k = 0; k < 2; ++k) \
        acc[ai][bj][m][n] = __builtin_amdgcn_mfma_f32_16x16x32_bf16(Bt[n][k], At[m][k], acc[ai][bj][m][n], 0, 0, 0); __builtin_amdgcn_s_setprio(0); } while (0)
#define PG8_WAIT_V(n) asm volatile("s_waitcnt vmcnt(" #n ")" ::: "memory")
#define PG8_WAIT_L(n) asm volatile("s_waitcnt lgkmcnt(" #n ")" ::: "memory")
#define PG8_BAR __builtin_amdgcn_s_barrier()
#define PG8_SCHED __builtin_amdgcn_sched_barrier(0)
    Unit cur, nxt; int ui = 0;
    if (!S.next(0, cur)) return;
    Acc acc;
#pragma unroll
    for (int a = 0; a < 2; ++a)
#pragma unroll
        for (int b = 0; b < 2; ++b)
#pragma unroll
            for (int m = 0; m < 4; ++m)
#pragma unroll
                for (int n = 0; n < 2; ++n) acc[a][b][m][n] = (f32x4){0.f, 0.f, 0.f, 0.f};
    bf16x8 At[4][2], B0[2][2], B1[2][2];
    const char* cA = (const char*)g.A + (size_t)cur.pm * tstepA; const char* cB = (const char*)g.Bt + (size_t)cur.pn * tstepB;
    PG8_STAGE(PG8_SB(0, 0), cB, voffB); PG8_STAGE(PG8_SB(0, 1), cB + hstepB, voffB); PG8_STAGE(PG8_SA(0, 0), cA, voffA); PG8_STAGE(PG8_SA(0, 1), cA + hstepA, voffA);
    if (wr == 1) PG8_BAR;
    PG8_WAIT_V(2); PG8_BAR;
    PG8_STAGE(PG8_SB(1, 0), cB + kstep, voffB); PG8_STAGE(PG8_SA(1, 0), cA + kstep, voffA); PG8_STAGE(PG8_SB(1, 1), cB + hstepB + kstep, voffB);
    PG8_WAIT_V(6); PG8_BAR;
    for (;;) {
        const bool has_next = S.next(ui + 1, nxt);
        const char* nA = has_next ? (const char*)((g.A2 && S.sub_n > 0 && ui + 1 >= (S.nwg + S.G - 1) / S.G) ? g.A2 : g.A) + (size_t)nxt.pm * tstepA : cA; const char* nB = has_next ? (const char*)g.Bt + (size_t)nxt.pn * tstepB : cB;
        for (int t = 0; t < nt; t += 2) {
            const bool last = (t == nt - 2);
            const char* a1 = cA + (size_t)(t + 1) * kstep;
            const char* a2 = last ? nA : cA + (size_t)(t + 2) * kstep; const char* b2 = last ? nB : cB + (size_t)(t + 2) * kstep;
            const char* a3 = a2 + kstep; const char* b3 = b2 + kstep;
            if constexpr (Epi::HAS_MID) { if (t == Epi::MID_T) { E.mid(acc, cur, wr, wc, fr, fq); PG8_SCHED; } }
            PG8_LDB(B0, 0, 0); PG8_LDB(B1, 0, 1); PG8_SCHED; PG8_LDA(At, 0, 0); PG8_STAGE(PG8_SA(1, 1), a1 + hstepA, voffA);
            PG8_WAIT_V(8); PG8_WAIT_L(0); PG8_BAR; PG8_MMA(0, 0, At, B0); PG8_MMA(0, 1, At, B1); PG8_BAR; PG8_SCHED;
            PG8_LDA(At, 0, 1); PG8_STAGE(PG8_SB(0, 0), b2, voffB); PG8_STAGE(PG8_SB(0, 1), b2 + hstepB, voffB); PG8_STAGE(PG8_SA(0, 0), a2, voffA);
            PG8_WAIT_V(8); PG8_WAIT_L(0); PG8_BAR; PG8_MMA(1, 0, At, B0); PG8_MMA(1, 1, At, B1); PG8_BAR; PG8_SCHED;
            PG8_LDB(B0, 1, 0); PG8_LDB(B1, 1, 1); PG8_SCHED; PG8_LDA(At, 1, 0); PG8_STAGE(PG8_SA(0, 1), a2 + hstepA, voffA);
            PG8_WAIT_V(8); PG8_WAIT_L(0); PG8_BAR; PG8_MMA(0, 0, At, B0); PG8_MMA(0, 1, At, B1); PG8_BAR; PG8_SCHED;
            PG8_LDA(At, 1, 1); PG8_STAGE(PG8_SB(1, 0), b3, voffB); PG8_STAGE(PG8_SB(1, 1), b3 + hstepB, voffB); PG8_STAGE(PG8_SA(1, 0), a3, voffA);
            PG8_WAIT_V(8); PG8_WAIT_L(0); PG8_BAR; PG8_MMA(1, 0, At, B0); PG8_MMA(1, 1, At, B1); PG8_BAR; PG8_SCHED;
        }
        if (wr == 0) PG8_BAR;
        if (!(PROBE_NOEPI && S.sub_n > 0 && ui >= (S.nwg + S.G - 1) / S.G)) E(acc, cur, wr, wc, fr, fq, xlds);
        if (!has_next) break;
        if (ROUND_SYNC && S.rcnt) {
            if (tid == 0) { const unsigned old = __hip_atomic_fetch_add(S.rcnt, 1u, __ATOMIC_RELAXED, __HIP_MEMORY_SCOPE_AGENT); const unsigned target = (old / S.nloc + 1u) * S.nloc; unsigned sp = 0;
                while (__hip_atomic_load(S.rcnt, __ATOMIC_RELAXED, __HIP_MEMORY_SCOPE_AGENT) < target) { __builtin_amdgcn_s_sleep(1); if (++sp > (1u << 16)) break; } }
            PG8_BAR;
        }
#pragma unroll
        for (int a = 0; a < 2; ++a)
#pragma unroll
            for (int b = 0; b < 2; ++b)
#pragma unroll
                for (int m = 0; m < 4; ++m)
#pragma unroll
                    for (int n = 0; n < 2; ++n) acc[a][b][m][n] = (f32x4){0.f, 0.f, 0.f, 0.f};
        cur = nxt; cA = nA; cB = nB; ++ui;
        if (wr == 1) PG8_BAR;
    }
    PG8_WAIT_V(0);
    PG8_BAR;
#undef PG8_SA
#undef PG8_SB
#undef PG8_STAGE
#undef PG8_LDA
#undef PG8_LDB
#undef PG8_MMA
#undef PG8_WAIT_V
#undef PG8_WAIT_L
#undef PG8_BAR
#undef PG8_SCHED
}
}

namespace att {
constexpr int SLOTB = 8192, NSLOT = 6;
constexpr int L_K = 0, L_V = NSLOT * SLOTB, L_OST = 2 * NSLOT * SLOTB, L_WS = RING_BYTES, L_SINK = L_WS + 8 * 256, L_BIAS = L_SINK + 64, L_END = L_BIAS + 2 * 260 * 4;
static_assert(L_OST + 8 * 4096 <= RING_BYTES && L_END <= MISC_OFF, "attention LDS");
constexpr float THR = 8.0f;
typedef LAS const char* lds_cptr;
__device__ __forceinline__ int crow(int r, int hi) { return (r & 3) + 8 * (r >> 2) + 4 * hi; }
__device__ __forceinline__ void glds16(const void* gsrc, unsigned lds_dst) { unsigned keep;
    asm volatile("s_mov_b32 %0, m0\n\ts_mov_b32 m0, %2\n\ts_nop 0\n\tglobal_load_lds_dwordx4 %1, off\n\ts_mov_b32 m0, %0" : "=&s"(keep) : "v"(gsrc), "s"(lds_dst) : "memory"); }
#define ATT_WAIT_BAR(N) asm volatile("s_waitcnt vmcnt(" #N ") lgkmcnt(0)\n\ts_barrier" ::: "memory")
__device__ __forceinline__ float rowmax32(const f32x16& p0, const f32x16& p1) {
    float a = fmaxf(fmaxf(p0[0], p0[1]), p1[0]), b = fmaxf(fmaxf(p0[2], p0[3]), p1[1]); a = fmaxf(fmaxf(a, p1[2]), p1[3]);
#pragma unroll
    for (int r = 4; r < 16; r += 4) { a = fmaxf(fmaxf(a, p0[r]), p0[r + 1]); b = fmaxf(fmaxf(b, p0[r + 2]), p0[r + 3]); a = fmaxf(fmaxf(a, p1[r]), p1[r + 1]); b = fmaxf(fmaxf(b, p1[r + 2]), p1[r + 3]); }
    const float m = fmaxf(a, b);
    auto rr = __builtin_amdgcn_permlane32_swap(__float_as_uint(m), __float_as_uint(m), false, false);
    return fmaxf(__uint_as_float(rr[0]), __uint_as_float(rr[1]));
}
__device__ __forceinline__ void pv(f32x16* o, int vb, bf16x8 pa0, bf16x8 pa1, bf16x8 pa2, bf16x8 pa3) {
#pragma unroll
    for (int d0 = 0; d0 < 2; ++d0) { s16x4 lo[4], hi[4];
#pragma unroll
        for (int ks = 0; ks < 4; ++ks) {
            asm volatile("ds_read_b64_tr_b16 %0,%1 offset:%c2" : "=&v"(lo[ks]) : "v"(vb), "i"(d0 * 4096 + ks * 1024) : "memory");
            asm volatile("ds_read_b64_tr_b16 %0,%1 offset:%c2" : "=&v"(hi[ks]) : "v"(vb), "i"(d0 * 4096 + ks * 1024 + 512) : "memory"); }
        asm volatile("s_waitcnt lgkmcnt(0)" ::: "memory"); __builtin_amdgcn_sched_barrier(0);
#define ATT_PK(k) (bf16x8){lo[k][0], lo[k][1], lo[k][2], lo[k][3], hi[k][0], hi[k][1], hi[k][2], hi[k][3]}
        o[d0] = __builtin_amdgcn_mfma_f32_32x32x16_bf16(pa0, ATT_PK(0), o[d0], 0, 0, 0);
        o[d0] = __builtin_amdgcn_mfma_f32_32x32x16_bf16(pa1, ATT_PK(1), o[d0], 0, 0, 0);
        o[d0] = __builtin_amdgcn_mfma_f32_32x32x16_bf16(pa2, ATT_PK(2), o[d0], 0, 0, 0);
        o[d0] = __builtin_amdgcn_mfma_f32_32x32x16_bf16(pa3, ATT_PK(3), o[d0], 0, 0, 0);
#undef ATT_PK
    }
}
typedef short v4i16_t __attribute__((ext_vector_type(4)));
struct VFrag { s16x4 lo[8], hi[8]; };
__device__ __forceinline__ void vload(VFrag& f, lds_cptr vp) {
#pragma unroll
    for (int d0 = 0; d0 < 2; ++d0)
#pragma unroll
        for (int ks = 0; ks < 4; ++ks) {
            f.lo[d0 * 4 + ks] = __builtin_bit_cast(s16x4, __builtin_amdgcn_ds_read_tr16_b64_v4i16((LAS v4i16_t*)(vp + d0 * 4096 + ks * 1024)));
            f.hi[d0 * 4 + ks] = __builtin_bit_cast(s16x4, __builtin_amdgcn_ds_read_tr16_b64_v4i16((LAS v4i16_t*)(vp + d0 * 4096 + ks * 1024 + 512))); }
}
__device__ __forceinline__ void pv2(f32x16* o, const VFrag& f, bf16x8 pa0, bf16x8 pa1, bf16x8 pa2, bf16x8 pa3) {
#define ATT_VF(i) (bf16x8){f.lo[i][0], f.lo[i][1], f.lo[i][2], f.lo[i][3], f.hi[i][0], f.hi[i][1], f.hi[i][2], f.hi[i][3]}
    o[0] = __builtin_amdgcn_mfma_f32_32x32x16_bf16(pa0, ATT_VF(0), o[0], 0, 0, 0); o[1] = __builtin_amdgcn_mfma_f32_32x32x16_bf16(pa0, ATT_VF(4), o[1], 0, 0, 0);
    o[0] = __builtin_amdgcn_mfma_f32_32x32x16_bf16(pa1, ATT_VF(1), o[0], 0, 0, 0); o[1] = __builtin_amdgcn_mfma_f32_32x32x16_bf16(pa1, ATT_VF(5), o[1], 0, 0, 0);
    o[0] = __builtin_amdgcn_mfma_f32_32x32x16_bf16(pa2, ATT_VF(2), o[0], 0, 0, 0); o[1] = __builtin_amdgcn_mfma_f32_32x32x16_bf16(pa2, ATT_VF(6), o[1], 0, 0, 0);
    o[0] = __builtin_amdgcn_mfma_f32_32x32x16_bf16(pa3, ATT_VF(3), o[0], 0, 0, 0); o[1] = __builtin_amdgcn_mfma_f32_32x32x16_bf16(pa3, ATT_VF(7), o[1], 0, 0, 0);
#undef ATT_VF
}
struct AU { const bf16_t* Qw; const bf16_t* Kt0; const bf16_t* Vt0; bf16_t* Ow; int j0, NT, wlo, whi; float sink2; int bias_off, jrel0, qq0; };
template <int MODE, bool SMP>
__device__ __forceinline__ void attn_unit(char* shm, const AU u, const int kpitch, const int qpitch, const bool pre, const bool has_next, const AU nx, bf16x8 (&qr)[4]) {
    const bf16_t* Qw = u.Qw; const bf16_t* Kt0 = u.Kt0; const bf16_t* Vt0 = u.Vt0; bf16_t* Ow = u.Ow;
    const int j0 = u.j0, NT = u.NT, wlo = u.wlo, whi = u.whi, bias_off = u.bias_off, jrel0 = u.jrel0, qq0 = u.qq0; const float sink2 = u.sink2;
    const int tid = threadIdx.x, lane = tid & 63, r32 = lane & 31, hi = lane >> 5; const int wid = __builtin_amdgcn_readfirstlane(tid >> 6);
    const unsigned lds0 = (unsigned)(uintptr_t)shm;
    LAS float* wsf = (LAS float*)((LAS char*)shm + L_WS) + wid * 64;
    const long koffl = (long)lane * kpitch + wid * 8, voffl = (long)(16 * (wid & 3) + (lane >> 2)) * kpitch + (wid >> 2) * 32 + (lane & 3) * 8;
    const bf16_t* ksrc = Kt0 + koffl;
    const bf16_t* vsrc = Vt0 + voffl;
    const unsigned kdst = lds0 + L_K + wid * 1024, vdst = lds0 + L_V + wid * 1024;
#define ATT_DMA(t, slot) do { glds16(ksrc + (long)(t) * 64 * kpitch, (unsigned)__builtin_amdgcn_readfirstlane(kdst + (slot))); glds16(vsrc + (long)(t) * 64 * kpitch, (unsigned)__builtin_amdgcn_readfirstlane(vdst + (slot))); } while (0)
    const int vb0 = (int)(lds0 + L_V) + ((lane >> 4) & 1) * 32 + (lane & 3) * 8 + (4 * hi + ((lane & 15) >> 2)) * 64;
    const lds_cptr kp0 = (lds_cptr)shm + L_K + hi * 1024 + r32 * 16;
    const lds_cptr vp0 = (lds_cptr)shm + L_V + ((lane >> 4) & 1) * 32 + (lane & 3) * 8 + (4 * hi + ((lane & 15) >> 2)) * 64;
    if (!pre) {
#pragma unroll
        for (int d0 = 0; d0 < 4; ++d0) qr[d0] = *reinterpret_cast<const bf16x8*>(Qw + (long)r32 * qpitch + d0 * 16 + hi * 8);
    }
    asm volatile("s_waitcnt vmcnt(0)" ::: "memory");
#pragma unroll
    for (int d0 = 0; d0 < 4; ++d0) asm volatile("" : "+v"(qr[d0]));
    if (!pre) { ATT_DMA(j0, 0); if (j0 + 1 < NT) ATT_DMA(j0 + 1, SLOTB); }
    float m_run = -1e30f, l_run = 0.f; f32x16 o[2]; o[0] = f32x16{}; o[1] = f32x16{};
    int sl_cur = 0, sl_nxt = SLOTB, sl_nn = 2 * SLOTB;
    const int qq = qq0 + r32;
    for (int j = j0; j < NT; ++j) {
        if (j + 1 < NT) { ATT_WAIT_BAR(2); } else { ATT_WAIT_BAR(0); }
        if (j + 2 < NT) ATT_DMA(j + 2, sl_nn);
        if (j >= wlo && j <= whi) {
            f32x16 p0, p1;
            { const lds_cptr kb = kp0 + sl_cur; const f32x16 z = f32x16{};
#pragma unroll
              for (int d0 = 0; d0 < 4; ++d0) {
                  const bf16x8 b0 = *(const LAS bf16x8*)(kb + d0 * 2048), b1 = *(const LAS bf16x8*)(kb + d0 * 2048 + 512);
                  if (d0 == 0) { p0 = __builtin_amdgcn_mfma_f32_32x32x16_bf16(b0, qr[0], z, 0, 0, 0); p1 = __builtin_amdgcn_mfma_f32_32x32x16_bf16(b1, qr[0], z, 0, 0, 0); }
                  else { p0 = __builtin_amdgcn_mfma_f32_32x32x16_bf16(b0, qr[d0], p0, 0, 0, 0); p1 = __builtin_amdgcn_mfma_f32_32x32x16_bf16(b1, qr[d0], p1, 0, 0, 0); } } }
            VFrag vf; vload(vf, vp0 + sl_cur);
            if (MODE == 1) {
                const LAS float* bt = (const LAS float*)((LAS char*)shm + bias_off);
                const int jr = j - jrel0;
                if (jr <= 5) { const float b0 = bt[0];
#pragma unroll
                    for (int r = 0; r < 16; ++r) { p0[r] += b0; p1[r] += b0; } }
                else { const int base = 64 * (jr - 8) + 128 - qq + 4 * hi;
#pragma unroll
                    for (int r = 0; r < 16; ++r) { const int kv = (r & 3) + 8 * (r >> 2); int i0 = base + kv, i1 = base + kv + 32; i0 = i0 < 0 ? 0 : (i0 > 256 ? 256 : i0); i1 = i1 < 0 ? 0 : (i1 > 256 ? 256 : i1);
                        p0[r] += bt[i0]; p1[r] += bt[i1]; } }
            }
            if (SMP) { if (j == NT - 1) {
#pragma unroll
                for (int r = 0; r < 16; ++r) { if (crow(r, hi) >= 16) p0[r] = -1e30f; p1[r] = -1e30f; } } }
            const float rm = rowmax32(p0, p1);
            if (__any(rm > m_run + THR)) {
                const float mn = fmaxf(m_run, rm), alpha = __builtin_amdgcn_exp2f(m_run - mn); m_run = mn; l_run *= alpha;
                if (hi == 0) wsf[r32] = alpha;
                asm volatile("s_waitcnt lgkmcnt(0)" ::: "memory");
#pragma unroll
                for (int r = 0; r < 16; ++r) { const float f = wsf[crow(r, hi)]; o[0][r] *= f; o[1][r] *= f; }
            }
            float sa0 = 0.f, sa1 = 0.f, sa2 = 0.f, sa3 = 0.f;
#pragma unroll
            for (int r = 0; r < 16; r += 2) { p0[r] = __builtin_amdgcn_exp2f(p0[r] - m_run); p1[r] = __builtin_amdgcn_exp2f(p1[r] - m_run); p0[r + 1] = __builtin_amdgcn_exp2f(p0[r + 1] - m_run); p1[r + 1] = __builtin_amdgcn_exp2f(p1[r + 1] - m_run);
                sa0 += p0[r]; sa1 += p1[r]; sa2 += p0[r + 1]; sa3 += p1[r + 1]; }
            l_run += (sa0 + sa1) + (sa2 + sa3);
            u32x4 pw0, pw1, pw2, pw3;
            pw0 = (u32x4){cvt_pk_bf16(p0[0], p0[1]), cvt_pk_bf16(p0[2], p0[3]), cvt_pk_bf16(p0[4], p0[5]), cvt_pk_bf16(p0[6], p0[7])};
            pw1 = (u32x4){cvt_pk_bf16(p0[8], p0[9]), cvt_pk_bf16(p0[10], p0[11]), cvt_pk_bf16(p0[12], p0[13]), cvt_pk_bf16(p0[14], p0[15])};
            pw2 = (u32x4){cvt_pk_bf16(p1[0], p1[1]), cvt_pk_bf16(p1[2], p1[3]), cvt_pk_bf16(p1[4], p1[5]), cvt_pk_bf16(p1[6], p1[7])};
            pw3 = (u32x4){cvt_pk_bf16(p1[8], p1[9]), cvt_pk_bf16(p1[10], p1[11]), cvt_pk_bf16(p1[12], p1[13]), cvt_pk_bf16(p1[14], p1[15])};
            __builtin_amdgcn_sched_barrier(0);
            pv2(o, vf, __builtin_bit_cast(bf16x8, pw0), __builtin_bit_cast(bf16x8, pw1), __builtin_bit_cast(bf16x8, pw2), __builtin_bit_cast(bf16x8, pw3));
        }
        { const int t_ = sl_cur; sl_cur = sl_nxt; sl_nxt = sl_nn; sl_nn = t_; }
    }
    asm volatile("s_waitcnt lgkmcnt(0)\n\ts_barrier" ::: "memory");
    if (has_next) {
        const bf16_t* ksrc_n = nx.Kt0 + koffl; const bf16_t* vsrc_n = nx.Vt0 + voffl;
        glds16(ksrc_n + (long)nx.j0 * 64 * kpitch, (unsigned)__builtin_amdgcn_readfirstlane(kdst)); glds16(vsrc_n + (long)nx.j0 * 64 * kpitch, (unsigned)__builtin_amdgcn_readfirstlane(vdst));
        if (nx.j0 + 1 < nx.NT) { glds16(ksrc_n + (long)(nx.j0 + 1) * 64 * kpitch, (unsigned)__builtin_amdgcn_readfirstlane(kdst + SLOTB)); glds16(vsrc_n + (long)(nx.j0 + 1) * 64 * kpitch, (unsigned)__builtin_amdgcn_readfirstlane(vdst + SLOTB)); }
#pragma unroll
        for (int d0 = 0; d0 < 4; ++d0) qr[d0] = *reinterpret_cast<const bf16x8*>(nx.Qw + (long)r32 * qpitch + d0 * 16 + hi * 8);
    }
    { auto rr = __builtin_amdgcn_permlane32_swap(__float_as_uint(l_run), __float_as_uint(l_run), false, false); l_run = __uint_as_float(rr[0]) + __uint_as_float(rr[1]); }
    if (MODE == 0) l_run += __builtin_amdgcn_exp2f(sink2 - m_run);
    if (hi == 0) wsf[32 + r32] = l_run;
    asm volatile("s_waitcnt lgkmcnt(0)" ::: "memory");
    float rli[16];
#pragma unroll
    for (int r = 0; r < 16; ++r) rli[r] = __builtin_amdgcn_rcpf(wsf[32 + crow(r, hi)]);
    { LAS bf16_t* stg = (LAS bf16_t*)((LAS char*)shm + L_OST) + wid * 2048;
#pragma unroll
      for (int r = 0; r < 16; ++r) { const int orow = crow(r, hi);
#pragma unroll
          for (int d0 = 0; d0 < 2; ++d0) stg[orow * 64 + d0 * 32 + r32] = (bf16_t)f2bf(o[d0][r] * rli[r]); }
      asm volatile("s_waitcnt lgkmcnt(0)" ::: "memory");
#pragma unroll
      for (int i = 0; i < (SMP ? 2 : 4); ++i) { const int row = i * 8 + (lane >> 3), ch = lane & 7; const u32x4 v = *(const LAS u32x4*)(stg + row * 64 + ch * 8); if (!SMP || wlo <= whi) *(u32x4*)(Ow + (long)row * AP + ch * 8) = v; } }
    if (!has_next) asm volatile("s_waitcnt vmcnt(0) lgkmcnt(0)\n\ts_barrier" ::: "memory");
#undef ATT_DMA
}

struct AUB { const bf16_t* Qw; const bf16_t* Kt0; const bf16_t* Vt0; bf16_t* Ow; int j0; };
__device__ __forceinline__ void attn_unit_bw(char* shm, const AUB u, const bool pre, const bool has_next, const AUB nx, const int bias_off, const int qq0, bf16x8 (&qr)[4]) {
    const int tid = threadIdx.x, lane = tid & 63, r32 = lane & 31, hi = lane >> 5; const int wid = __builtin_amdgcn_readfirstlane(tid >> 6);
    const int co = wid >> 1, j0 = u.j0, s0 = j0 > 3 ? j0 - 3 : 0;
    const unsigned lds0 = (unsigned)(uintptr_t)shm;
    LAS float* wsf = (LAS float*)((LAS char*)shm + L_WS) + wid * 64;
    const long koffl = (long)lane * 64 + wid * 8, voffl = (long)(16 * (wid & 3) + (lane >> 2)) * 64 + (wid >> 2) * 32 + (lane & 3) * 8;
    const unsigned kdst = lds0 + L_K + wid * 1024, vdst = lds0 + L_V + wid * 1024;
#define ATT_SLOT(t) ((((t) >= 6) ? (t) - 6 : (t)) * SLOTB)
#define ATT_DMAB(U, t) do { const int sl_ = ATT_SLOT(t); glds16((U).Kt0 + koffl + (long)(t) * 4096, (unsigned)__builtin_amdgcn_readfirstlane(kdst + sl_)); glds16((U).Vt0 + voffl + (long)(t) * 4096, (unsigned)__builtin_amdgcn_readfirstlane(vdst + sl_)); } while (0)
    const int vb0 = (int)(lds0 + L_V) + ((lane >> 4) & 1) * 32 + (lane & 3) * 8 + (4 * hi + ((lane & 15) >> 2)) * 64;
    const lds_cptr kp0 = (lds_cptr)shm + L_K + hi * 1024 + r32 * 16;
    const lds_cptr vp0 = (lds_cptr)shm + L_V + ((lane >> 4) & 1) * 32 + (lane & 3) * 8 + (4 * hi + ((lane & 15) >> 2)) * 64;
    if (!pre) {
#pragma unroll
        for (int d0 = 0; d0 < 4; ++d0) qr[d0] = *reinterpret_cast<const bf16x8*>(u.Qw + (long)r32 * 64 + d0 * 16 + hi * 8);
    }
    asm volatile("s_waitcnt vmcnt(0)" ::: "memory");
#pragma unroll
    for (int d0 = 0; d0 < 4; ++d0) asm volatile("" : "+v"(qr[d0]));
    if (!pre) { for (int t = j0; t <= s0 + 4; ++t) ATT_DMAB(u, t); }
    float m_run = 0.f, l_run = 0.f; f32x16 o[2]; o[0] = f32x16{}; o[1] = f32x16{};
    bool fresh = true;
    const int qq = qq0 + r32;
    const LAS float* bt = (const LAS float*)((LAS char*)shm + bias_off);
    const float bfar = bt[0];
    for (int s = s0; s < 9; ++s) {
        if (s + 4 <= 11) { ATT_WAIT_BAR(2); } else { ATT_WAIT_BAR(0); }
        if (s + 5 <= 11) ATT_DMAB(u, s + 5);
        const int t = s + co;
        if (t >= j0) {
            const int sl = ATT_SLOT(t);
            f32x16 p0, p1;
            { const lds_cptr kb = kp0 + sl; const float c0 = (s <= 5 ? bfar : 0.f) - m_run; f32x16 z;
#pragma unroll
              for (int r = 0; r < 16; ++r) z[r] = c0;
#pragma unroll
              for (int d0 = 0; d0 < 4; ++d0) {
                  const bf16x8 b0 = *(const LAS bf16x8*)(kb + d0 * 2048), b1 = *(const LAS bf16x8*)(kb + d0 * 2048 + 512);
                  if (d0 == 0) { p0 = __builtin_amdgcn_mfma_f32_32x32x16_bf16(b0, qr[0], z, 0, 0, 0); p1 = __builtin_amdgcn_mfma_f32_32x32x16_bf16(b1, qr[0], z, 0, 0, 0); }
                  else { p0 = __builtin_amdgcn_mfma_f32_32x32x16_bf16(b0, qr[d0], p0, 0, 0, 0); p1 = __builtin_amdgcn_mfma_f32_32x32x16_bf16(b1, qr[d0], p1, 0, 0, 0); } } }
            VFrag vf; vload(vf, vp0 + sl);
            if (s == 6) { const int base = 64 * (6 - 8) + 128 - qq + 4 * hi;
#pragma unroll
                for (int r = 0; r < 16; ++r) { const int kv = (r & 3) + 8 * (r >> 2); int i0 = base + kv, i1 = base + kv + 32; i0 = i0 < 0 ? 0 : i0; i1 = i1 < 0 ? 0 : i1; p0[r] += bt[i0]; p1[r] += bt[i1]; } }
            else if (s >= 7) { const LAS float* bb = bt + (64 * (s - 8) + 128 - qq + 4 * hi);
#pragma unroll
                for (int r = 0; r < 16; ++r) { const int kv = (r & 3) + 8 * (r >> 2); p0[r] += bb[kv]; p1[r] += bb[kv + 32]; } }
            const float rm = rowmax32(p0, p1);
            if (fresh || __any(rm > THR)) {
                const float dl = fresh ? rm : fmaxf(rm, 0.f), alpha = __builtin_amdgcn_exp2f(-dl); m_run += dl; l_run *= alpha; fresh = false;
#pragma unroll
                for (int r = 0; r < 16; ++r) { p0[r] -= dl; p1[r] -= dl; }
                if (hi == 0) wsf[r32] = alpha;
                asm volatile("s_waitcnt lgkmcnt(0)" ::: "memory");
#pragma unroll
                for (int r = 0; r < 16; ++r) { const float f = wsf[crow(r, hi)]; o[0][r] *= f; o[1][r] *= f; }
            }
            float sa0 = 0.f, sa1 = 0.f, sa2 = 0.f, sa3 = 0.f;
#pragma unroll
            for (int r = 0; r < 16; r += 2) { p0[r] = __builtin_amdgcn_exp2f(p0[r]); p1[r] = __builtin_amdgcn_exp2f(p1[r]); p0[r + 1] = __builtin_amdgcn_exp2f(p0[r + 1]); p1[r + 1] = __builtin_amdgcn_exp2f(p1[r + 1]);
                sa0 += p0[r]; sa1 += p1[r]; sa2 += p0[r + 1]; sa3 += p1[r + 1]; }
            l_run += (sa0 + sa1) + (sa2 + sa3);
            u32x4 pw0, pw1, pw2, pw3;
            pw0 = (u32x4){cvt_pk_bf16(p0[0], p0[1]), cvt_pk_bf16(p0[2], p0[3]), cvt_pk_bf16(p0[4], p0[5]), cvt_pk_bf16(p0[6], p0[7])};
            pw1 = (u32x4){cvt_pk_bf16(p0[8], p0[9]), cvt_pk_bf16(p0[10], p0[11]), cvt_pk_bf16(p0[12], p0[13]), cvt_pk_bf16(p0[14], p0[15])};
            pw2 = (u32x4){cvt_pk_bf16(p1[0], p1[1]), cvt_pk_bf16(p1[2], p1[3]), cvt_pk_bf16(p1[4], p1[5]), cvt_pk_bf16(p1[6], p1[7])};
            pw3 = (u32x4){cvt_pk_bf16(p1[8], p1[9]), cvt_pk_bf16(p1[10], p1[11]), cvt_pk_bf16(p1[12], p1[13]), cvt_pk_bf16(p1[14], p1[15])};
            __builtin_amdgcn_sched_barrier(0);
            pv2(o, vf, __builtin_bit_cast(bf16x8, pw0), __builtin_bit_cast(bf16x8, pw1), __builtin_bit_cast(bf16x8, pw2), __builtin_bit_cast(bf16x8, pw3));
        }
    }
    asm volatile("s_waitcnt lgkmcnt(0)\n\ts_barrier" ::: "memory");
    if (has_next) {
        const int nj0 = nx.j0, ns0 = nj0 > 3 ? nj0 - 3 : 0;
        for (int t = nj0; t <= ns0 + 4; ++t) ATT_DMAB(nx, t);
#pragma unroll
        for (int d0 = 0; d0 < 4; ++d0) qr[d0] = *reinterpret_cast<const bf16x8*>(nx.Qw + (long)r32 * 64 + d0 * 16 + hi * 8);
    }
    { auto rr = __builtin_amdgcn_permlane32_swap(__float_as_uint(l_run), __float_as_uint(l_run), false, false); l_run = __uint_as_float(rr[0]) + __uint_as_float(rr[1]); }
    if (hi == 0) wsf[32 + r32] = l_run;
    asm volatile("s_waitcnt lgkmcnt(0)" ::: "memory");
    float rli[16];
#pragma unroll
    for (int r = 0; r < 16; ++r) rli[r] = __builtin_amdgcn_rcpf(wsf[32 + crow(r, hi)]);
    { LAS bf16_t* stg = (LAS bf16_t*)((LAS char*)shm + L_OST) + wid * 2048;
#pragma unroll
      for (int r = 0; r < 16; ++r) { const int orow = crow(r, hi);
#pragma unroll
          for (int d0 = 0; d0 < 2; ++d0) stg[orow * 64 + d0 * 32 + r32] = (bf16_t)f2bf(o[d0][r] * rli[r]); }
      asm volatile("s_waitcnt lgkmcnt(0)" ::: "memory");
#pragma unroll
      for (int i = 0; i < 4; ++i) { const int row = i * 8 + (lane >> 3), ch = lane & 7; const u32x4 v = *(const LAS u32x4*)(stg + row * 64 + ch * 8); *(u32x4*)(u.Ow + (long)row * AP + ch * 8) = v; } }
    if (!has_next) asm volatile("s_waitcnt vmcnt(0) lgkmcnt(0)\n\ts_barrier" ::: "memory");
#undef ATT_DMAB
#undef ATT_SLOT
}
}

#define XB_TMO      128
#define XB_XCNT(j)  (256  + 64 * (j))
#define XB_XSUB(j)  (1280 + 64 * (j))
#define XB_XGEN(j)  (2304 + 64 * (j))
#define XB_TOP      3328
#define XB_TOPGEN   3392
#define XCD_BAR_WORDS 3456
#define XB_SPIN_CAP (1u << 20)
__device__ __forceinline__ unsigned xb_ld(unsigned* p)              { return __hip_atomic_load(p, __ATOMIC_RELAXED, __HIP_MEMORY_SCOPE_AGENT); }
__device__ __forceinline__ unsigned xb_add(unsigned* p, unsigned v) { return __hip_atomic_fetch_add(p, v, __ATOMIC_RELAXED, __HIP_MEMORY_SCOPE_AGENT); }
__device__ __forceinline__ unsigned xb_xcc_id() { return (unsigned)__builtin_amdgcn_s_getreg((3 << 11) | 20) & 0xFu; }
#define XB_SPIN(cond, bar) do { unsigned _sp = 0; while (cond) { __builtin_amdgcn_s_sleep(1); \
    if ((++_sp & 255u) == 0u) { if (xb_ld(&(bar)[XB_TMO])) break; if (_sp > XB_SPIN_CAP) { atomicAdd(&(bar)[XB_TMO], 1u); break; } } } } while (0)
struct XcdBarrier { unsigned* bar; unsigned x; volatile LAS unsigned* st; };
__device__ __forceinline__ XcdBarrier xcd_barrier_post(unsigned* bar, volatile LAS unsigned* st) {
    XcdBarrier b; b.bar = bar; b.x = xb_xcc_id(); b.st = st;
    if (threadIdx.x == 0) (void)xb_add(&bar[XB_XCNT(b.x)], 1u);
    return b;
}
__device__ __forceinline__ void xcd_barrier_complete(unsigned* bar, unsigned x, unsigned& nloc, unsigned& nx) {
    const unsigned G = gridDim.x * gridDim.y * gridDim.z;
    unsigned sum, cnt, mine, sp = 0u;
    for (;;) {
        sum = 0u; cnt = 0u; mine = 0u;
#pragma unroll
        for (unsigned j = 0; j < 16; ++j) { const unsigned c = xb_ld(&bar[XB_XCNT(j)]); sum += c; cnt += (c > 0u) ? 1u : 0u; mine = (j == x) ? c : mine; }
        if (sum == G) break;
        __builtin_amdgcn_s_sleep(1);
        if ((++sp & 255u) == 0u) { if (xb_ld(&bar[XB_TMO])) break; if (sp > XB_SPIN_CAP) { atomicAdd(&bar[XB_TMO], 1u); break; } }
    }
    nloc = mine > 0u ? mine : 1u; nx = cnt > 0u ? cnt : 1u;
}
__device__ __forceinline__ void xcd_barrier(const XcdBarrier& b) {
    asm volatile("s_waitcnt vmcnt(0)" ::: "memory");
    __syncthreads();
    if (threadIdx.x == 0) {
        unsigned* bar = b.bar;
        __builtin_amdgcn_s_waitcnt(0);
        unsigned nloc = b.st[0], nx = b.st[1];
        if (nloc == 0u) { xcd_barrier_complete(bar, b.x, nloc, nx); b.st[0] = nloc; b.st[1] = nx; }
        const unsigned old = xb_add(&bar[XB_XSUB(b.x)], 1u);
        const unsigned gen = old / nloc;
        if (old + 1u == (gen + 1u) * nloc) {
            __builtin_amdgcn_fence(__ATOMIC_RELEASE, "agent");
            asm volatile("s_waitcnt vmcnt(0)" ::: "memory");
            const unsigned og = xb_add(&bar[XB_TOP], 1u);
            const unsigned tg = og / nx;
            if (og + 1u == (tg + 1u) * nx) xb_add(&bar[XB_TOPGEN], 1u);
            else XB_SPIN(xb_ld(&bar[XB_TOPGEN]) == tg, bar);
            __builtin_amdgcn_fence(__ATOMIC_ACQUIRE, "agent");
            xb_add(&bar[XB_XGEN(b.x)], 1u);
            asm volatile("s_waitcnt vmcnt(0)" ::: "memory");
        } else {
            XB_SPIN(xb_ld(&bar[XB_XGEN(b.x)]) == gen, bar);
            __builtin_amdgcn_fence(__ATOMIC_ACQUIRE, "agent");
            asm volatile("s_waitcnt vmcnt(0)" ::: "memory");
        }
    }
    __syncthreads();
}

struct Args { const float* in[21]; float* out; unsigned char* ws; int ph_lo, ph_hi; };
struct Frame {
    LAS unsigned char* lds; int tid, lane, wave, vcu, G;
    const float* in[21]; float* out; unsigned char* ws;
};
#define LDS_WAIT() asm volatile("s_waitcnt lgkmcnt(0)" ::: "memory")
#define VM_WAIT() asm volatile("s_waitcnt vmcnt(0)" ::: "memory")

__device__ __forceinline__ void transpose_item(const float* W, int N, bf16_t* WT, int ldd, int koff, int kind, LAS float* scr, int item, int lane, const float* gk = nullptr) {
    const int nblk = N / 32, kb = item / nblk, nb = item % nblk, k0 = 64 * kb, n0 = 32 * nb;
#pragma unroll 8
    for (int i = 0; i < 32; ++i) { const int kk = 2 * i + (lane >> 5); scr[kk * 33 + (lane & 31)] = W[(size_t)(k0 + kk) * N + n0 + (lane & 31)] * (gk ? gk[k0 + kk] : 1.0f); }
    LDS_WAIT(); asm volatile("" ::: "memory");
    const int c = lane & 7;
#pragma unroll
    for (int j = 0; j < 4; ++j) { const int n = (lane >> 3) + 8 * j; const LAS float* s = scr + (8 * c) * 33 + n;
        u32x4 o; o.x = pk2(s[0 * 33], s[1 * 33]); o.y = pk2(s[2 * 33], s[3 * 33]); o.z = pk2(s[4 * 33], s[5 * 33]); o.w = pk2(s[6 * 33], s[7 * 33]);
        const int nn = n0 + n; const int dr = kind == 1 ? gcol_in(nn) : (kind == 2 ? gcol_up(nn) : nn);
        *(u32x4*)(WT + (size_t)dr * ldd + koff + k0 + 8 * c) = o; }
    LDS_WAIT(); asm volatile("" ::: "memory");
}
__device__ __forceinline__ void rms_row_to_bf16(const float* xrow, const float* g, bf16_t* orow, int lane) {
    const f32x4* xr = (const f32x4*)xrow + lane; const f32x4* gr = (const f32x4*)g + lane;
    f32x4 v[4]; float s = 0.f;
#pragma unroll
    for (int j = 0; j < 4; ++j) { v[j] = xr[64 * j]; s += (v[j].x * v[j].x + v[j].y * v[j].y) + (v[j].z * v[j].z + v[j].w * v[j].w); }
    const float rstd = 1.0f / sqrtf(wave_sum(s) * (1.f / DM) + EPS);
    unsigned long long* o8 = (unsigned long long*)orow + lane;
#pragma unroll
    for (int j = 0; j < 4; ++j) { const f32x4 gg = gr[64 * j]; const f32x4 y = v[j] * rstd * gg; o8[64 * j] = (unsigned long long)pk2(y.x, y.y) | ((unsigned long long)pk2(y.z, y.w) << 32); }
}
__device__ __forceinline__ const float* xrow_ptr(const Frame& F, int m) { return m < MP ? F.in[0] + (size_t)m * DM : F.in[1] + (size_t)(m - MP) * DM; }
__device__ __forceinline__ float* yrow_ptr(const Frame& F, int m) { return m < MP ? F.out + O_YP + (size_t)m * DM : F.out + O_YS + (size_t)(m - MP) * DM; }

__device__ __forceinline__ f32x4 skinny(const bf16_t* A, int lda, const bf16_t* Bt, int ldb, int n0, int wave, int lane, int K, LAS unsigned char* red) {
    const int fr = lane & 15, fq = lane >> 4, kw = K >> 3;
    const bf16_t* ap = A + (size_t)fr * lda + wave * kw + 8 * fq; const bf16_t* bp = Bt + (size_t)(n0 + fr) * ldb + wave * kw + 8 * fq;
    f32x4 acc[8];
#pragma unroll
    for (int rb = 0; rb < 8; ++rb) acc[rb] = (f32x4){0.f, 0.f, 0.f, 0.f};
    int k0 = 0;
#pragma nounroll
    for (; k0 + 64 <= kw; k0 += 64) {
        bf16x8 b[2], a[2][8];
#pragma unroll
        for (int i = 0; i < 2; ++i) { b[i] = *(const bf16x8*)(bp + k0 + 32 * i);
#pragma unroll
            for (int rb = 0; rb < 8; ++rb) a[i][rb] = *(const bf16x8*)(ap + (size_t)(16 * rb) * lda + k0 + 32 * i); }
        __builtin_amdgcn_sched_barrier(0);
#pragma unroll
        for (int i = 0; i < 2; ++i)
#pragma unroll
            for (int rb = 0; rb < 8; ++rb) acc[rb] = __builtin_amdgcn_mfma_f32_16x16x32_bf16(a[i][rb], b[i], acc[rb], 0, 0, 0);
    }
#pragma nounroll
    for (; k0 < kw; k0 += 32) {
        const bf16x8 b = *(const bf16x8*)(bp + k0); bf16x8 a[8];
#pragma unroll
        for (int rb = 0; rb < 8; ++rb) a[rb] = *(const bf16x8*)(ap + (size_t)(16 * rb) * lda + k0);
        __builtin_amdgcn_sched_barrier(0);
#pragma unroll
        for (int rb = 0; rb < 8; ++rb) acc[rb] = __builtin_amdgcn_mfma_f32_16x16x32_bf16(a[rb], b, acc[rb], 0, 0, 0);
    }
    LAS f32x4* R = (LAS f32x4*)red;
#pragma unroll
    for (int rb = 0; rb < 8; ++rb) R[(wave * 8 + rb) * 64 + lane] = acc[rb];
    __syncthreads();
    f32x4 r = R[(0 * 8 + wave) * 64 + lane];
#pragma unroll
    for (int w2 = 1; w2 < 8; ++w2) r += R[(w2 * 8 + wave) * 64 + lane];
    __syncthreads();
    return r;
}

__global__ void __launch_bounds__(512, 2) fwd_kernel(Args args) {
    extern __shared__ __attribute__((aligned(16))) unsigned char lds_raw[];
    Frame F;
    F.lds = (LAS unsigned char*)lds_raw;
    F.tid = threadIdx.x; F.lane = F.tid & 63; F.wave = __builtin_amdgcn_readfirstlane(F.tid >> 6);
    F.G = gridDim.x; { const int bx = blockIdx.x; F.vcu = (F.G % 8 == 0) ? (bx % 8) * (F.G / 8) + bx / 8 : bx; }
#pragma unroll
    for (int i = 0; i < 21; ++i) F.in[i] = args.in[i];
    F.out = args.out; F.ws = args.ws;
    unsigned char* ws = args.ws;
    unsigned* ctl = (unsigned*)(ws + WS_CTL);
    volatile LAS unsigned* MISC = (volatile LAS unsigned*)(F.lds + MISC_OFF);
    for (int u = F.tid; u < 64; u += 512) MISC[u] = 0u;
    __syncthreads();
    const int lo = args.ph_lo, hi = args.ph_hi;
    const bool one_launch = (hi - lo) > 1;
    XcdBarrier bar; bar.bar = ctl + CW_BAR; bar.x = 0; bar.st = nullptr;
    if (one_launch) bar = xcd_barrier_post(ctl + CW_BAR, MISC + 8);
#define IN(k) (lo <= (k) && (k) < hi)
#define RSYNC(S, k) do { if (one_launch) { (S).nloc = MISC[8]; (S).rcnt = ctl + CW_ROUND + 1024 * (k) + 64 * bar.x; if ((S).nloc == 0u) (S).rcnt = nullptr; } } while (0)
#define GRID_BAR(k) do { if (IN(k) && IN((k) + 1)) xcd_barrier(bar); } while (0)
    bf16_t* Win_t = (bf16_t*)(ws + WS_WIN); bf16_t* Woab_t = (bf16_t*)(ws + WS_WOAB); bf16_t* Wout_t = (bf16_t*)(ws + WS_WOUT); bf16_t* Wup_t = (bf16_t*)(ws + WS_WUP); bf16_t* Wd_t = (bf16_t*)(ws + WS_WD);
    float* CS = (float*)(ws + WS_CS); float* S1 = (float*)(ws + WS_S1); bf16_t* SKV = (bf16_t*)(ws + WS_SKV); float* RSTD0 = (float*)(ws + WS_RSTD0); float* RSTD1 = (float*)(ws + WS_RSTD1); bf16_t* SQ = (bf16_t*)(ws + WS_SQ);
    float* uhalo = (float*)(ws + WS_UHALO); float* fixu = (float*)(ws + WS_FIXU); float* fixv = (float*)(ws + WS_FIXV);
    bf16_t* XN = (bf16_t*)(ws + WS_XN); bf16_t* QKV = (bf16_t*)(ws + WS_QKV); bf16_t* GB = (bf16_t*)(ws + WS_G); bf16_t* OB = (bf16_t*)(ws + WS_O);
    bf16_t* X1B = (bf16_t*)(ws + WS_X1B); bf16_t* MIX = (bf16_t*)(ws + WS_QKV); bf16_t* GT = (bf16_t*)(ws + WS_QKV); bf16_t* ZB = (bf16_t*)(ws + WS_O); bf16_t* FB = (bf16_t*)(ws + WS_O);
    const int gw = F.vcu * 8 + F.wave, NGW = F.G * 8;
    LAS unsigned char* ring = F.lds; LAS unsigned char* xlds = F.lds + XLDS_OFF;

    if (IN(0)) for (int rep_ = 0; rep_ <= ((REPEAT_MASK >> 0) & 1); ++rep_) {
        LAS float* scr = (LAS float*)(F.lds + F.wave * 16384);
        constexpr int I_IN = 16 * (NIN / 32), I_OA = 8 * 32, I_OUT = 16 * 32, I_UP = 16 * (NUP / 32), I_D = (FF / 64) * 32;
        constexpr int NITEMS = I_IN + 2 * I_OA + I_OUT + I_UP + I_D;
        for (int it = gw; it < NITEMS; it += NGW) {
            int r = it;
            if (r < I_IN) { transpose_item(F.in[8], NIN, Win_t, AP, 0, 1, scr, r, F.lane, F.in[7]); continue; } r -= I_IN;
            if (r < I_OA) { transpose_item(F.in[11], DM, Woab_t, AP, 0, 0, scr, r, F.lane); continue; } r -= I_OA;
            if (r < I_OA) { transpose_item(F.in[12], DM, Woab_t, AP, 512, 0, scr, r, F.lane); continue; } r -= I_OA;
            if (r < I_OUT) { transpose_item(F.in[13], DM, Wout_t, AP, 0, 0, scr, r, F.lane); continue; } r -= I_OUT;
            if (r < I_UP) { transpose_item(F.in[16], NUP, Wup_t, AP, 0, 2, scr, r, F.lane, F.in[15]); continue; } r -= I_UP;
            transpose_item(F.in[19], DM, Wd_t, GTP, 0, 0, scr, r, F.lane);
        }
        for (int e = blockIdx.x * 512 + F.tid; e < SEQ * 32; e += F.G * 512) {
          { const int t = e >> 5, d = e & 31; const float inv = 1.0f / powf(10000.0f, (float)d * (2.0f / 64.0f)); const float ang = (float)t * inv;
              CS[(size_t)t * 64 + d] = cosf(ang); CS[(size_t)t * 64 + 32 + d] = sinf(ang); } }
        for (int it = gw; it < SB * SKVR; it += NGW) {
            const int b = it / SKVR, j = it % SKVR, l = F.lane; bf16_t* dst = SKV + (size_t)it * SKVP;
            if (j < 512) {
                const f32x4* kb = (const f32x4*)(F.in[4] + (size_t)(b * 512 + j) * 512); const f32x4* vb = (const f32x4*)(F.in[5] + (size_t)(b * 512 + j) * 512);
#pragma unroll
                for (int i = 0; i < 2; ++i) { const f32x4 a = kb[l + 64 * i], c = vb[l + 64 * i];
                    *(u32x2*)(dst + 4 * (l + 64 * i)) = (u32x2){pk2(a.x, a.y), pk2(a.z, a.w)}; *(u32x2*)(dst + 512 + 4 * (l + 64 * i)) = (u32x2){pk2(c.x, c.y), pk2(c.z, c.w)}; }
                if (j >= 384 && l < 32) {
                    const int g = l >> 4, i = l & 15, d0 = 4 * (i >> 1) + 32 * (i & 1);
                    const f32x4 a = *(const f32x4*)(F.in[2] + ((size_t)(b * 128 + (j - 384)) * 2 + g) * 64 + d0); const f32x4 c = *(const f32x4*)(F.in[3] + ((size_t)(b * 128 + (j - 384)) * 2) * 64 + 4 * l);
                    *(u32x2*)(dst + 1024 + 4 * l) = (u32x2){pk2(a.x, a.y), pk2(a.z, a.w)}; *(u32x2*)(dst + 1152 + 4 * l) = (u32x2){pk2(c.x, c.y), pk2(c.z, c.w)}; }
            } else if (j >= 528) {
#pragma unroll
                for (int i = 0; i < 5; ++i) *(u32x2*)(dst + 4 * (l + 64 * i)) = (u32x2){0u, 0u};
            }
        }
        for (int m0 = gw; m0 < MP + MS; m0 += 4 * NGW) {
            f32x4 v[4][4];
#pragma unroll
            for (int r = 0; r < 4; ++r) { const int m = m0 + r * NGW; const f32x4* xr = (const f32x4*)xrow_ptr(F, m < MP + MS ? m : m0) + F.lane;
#pragma unroll
                for (int j = 0; j < 4; ++j) v[r][j] = xr[64 * j]; }
            __builtin_amdgcn_sched_barrier(0);
#pragma unroll
            for (int r = 0; r < 4; ++r) { const int m = m0 + r * NGW; if (m >= MP + MS) break;
                float s = 0.f;
#pragma unroll
                for (int j = 0; j < 4; ++j) s += (v[r][j].x * v[r][j].x + v[r][j].y * v[r][j].y) + (v[r][j].z * v[r][j].z + v[r][j].w * v[r][j].w);
                const float rstd = 1.0f / sqrtf(wave_sum(s) * (1.f / DM) + EPS);
                if (F.lane == 0) RSTD0[m] = rstd;
                unsigned long long* o8 = (unsigned long long*)(XN + (size_t)m * AP) + F.lane;
#pragma unroll
                for (int j = 0; j < 4; ++j) { const f32x4 y = v[r][j]; o8[64 * j] = (unsigned long long)pk2(y.x, y.y) | ((unsigned long long)pk2(y.z, y.w) << 32); } }
        }
    }
    GRID_BAR(0);

    if (IN(1)) {
        for (int rs_ = 0; rs_ <= PROBE_SMP; ++rs_) for (int s = F.vcu; s < NIN / 16; s += F.G) {
            const int n0 = 16 * s; const f32x4 acc = skinny(XN + (size_t)MP * AP, AP, Win_t, AP, n0, F.wave, F.lane, DM, ring);
            const int fr = F.lane & 15, fq = F.lane >> 4, gc = n0 + fr, b = F.wave;
#pragma unroll
            for (int reg = 0; reg < 4; ++reg) {
                const int t = 4 * fq + reg, row = 16 * b + t; float val = acc[reg] * RSTD0[MP + row];
                const float partner = __shfl_xor(val, 4);
                if (gc < 640) {
                    const int j = gc & 63, q = j >> 3, e = j & 7, dd = 4 * q + (e & 3); const float cs = CS[(size_t)(PAST + t) * 64 + dd], sn = CS[(size_t)(PAST + t) * 64 + 32 + dd];
                    val = (e < 4) ? (val * cs - partner * sn) : (val * cs + partner * sn);
                }
                const int sc = src_in(gc);
                S1[(size_t)row * NIN + sc] = val;
                { bf16_t* kvr = SKV + ((size_t)b * SKVR + 512 + t) * SKVP;
                  if (gc < 512) SQ[(size_t)row * SQP + gc] = (bf16_t)f2bf(val * C2);
                  else if (gc < 640) kvr[1024 + (gc - 512)] = (bf16_t)f2bf(val);
                  else if (gc < 768) kvr[1152 + (gc - 640)] = (bf16_t)f2bf(val);
                  else if (gc < 1280) SQ[(size_t)row * SQP + 512 + (gc - 768)] = (bf16_t)f2bf(val * C2);
                  else if (gc < 1792) kvr[gc - 1280] = (bf16_t)f2bf(val);
                  else if (gc < 2304) kvr[512 + (gc - 1792)] = (bf16_t)f2bf(val); }
                if (sc >= 512 && sc < 640) F.out[O_AKS + (size_t)row * 128 + (sc - 512)] = val;
                else if (sc >= 640 && sc < 768) F.out[O_AVS + (size_t)row * 128 + (sc - 640)] = val;
                else if (sc >= 1280 && sc < 1792) F.out[O_BKS + (size_t)row * 512 + (sc - 1280)] = val;
                else if (sc >= 1792 && sc < 2304) F.out[O_BVS + (size_t)row * 512 + (sc - 1792)] = val;
            }
        }
        pg8::Gemm g{XN, Win_t, MP, NIN, DM, AP, AP}; pg8::StaticOrder S; S.init(MP, NIN, F.G, (int)blockIdx.x, 1 + ((REPEAT_MASK >> 1) & 1)); S.sub_n = PROBE_SUB_N; S.sub_o = PROBE_SUB_O; RSYNC(S, 1);
        pg8::EpiIn E{QKV, GB, CS, F.out, RSTD0};
        pg8::gemm_phase<pg8::EpiIn, pg8::StaticOrder>(ring, xlds, g, S, E);
    }
    GRID_BAR(1);

    if (IN(2)) for (int rep_ = 0; rep_ <= ((REPEAT_MASK >> 2) & 1); ++rep_) {
        char* shm = (char*)lds_raw;
        { LAS float* bt = (LAS float*)(F.lds + att::L_BIAS); const int h0 = (F.vcu >> 1) & 7, h1 = (F.vcu >> 1) & 7;
          for (int i = F.tid; i < 2 * 257; i += 512) { const int wh = i / 257, k = i % 257; bt[wh * 260 + k] = F.in[10][(wh ? h1 : h0) * 257 + k] * LOG2E; }
          LAS float* sk = (LAS float*)(F.lds + att::L_SINK); if (F.tid < 8) sk[F.tid] = F.in[9][F.tid] * LOG2E; }
        __syncthreads();
        bf16x8 qr[4];
        if ((F.vcu & 1) == 0 && (F.vcu >> 1) < 64) {
            const int su = F.vcu >> 1, b = su >> 3, h = su & 7, act = (F.wave == 0);
            const bf16_t* kv = SKV + (size_t)b * SKVR * SKVP;
            const att::AU u{SQ + (size_t)(16 * b) * SQP + 512 + 64 * h, kv + 64 * h, kv + 512 + 64 * h, OB + (size_t)(MP + 16 * b) * AP + 512 + 64 * h, 0, 9, act ? 0 : 1, act ? 8 : 0, 0.f, att::L_BIAS, 0, 0};
            att::attn_unit<1, true>(shm, u, SKVP, SQP, false, false, u, qr);
        } else if ((F.vcu & 1) == 1 && (F.vcu >> 1) < 16) {
            const int su = F.vcu >> 1, b = su >> 1, g = su & 1, act = (F.wave < 4), hq = 4 * g + (F.wave & 3);
            const LAS float* sk = (const LAS float*)(F.lds + att::L_SINK);
            const bf16_t* kv = SKV + ((size_t)b * SKVR + 384) * SKVP;
            const att::AU u{SQ + (size_t)(16 * b) * SQP + 64 * hq, kv + 1024 + 64 * g, kv + 1152 + 64 * g, OB + (size_t)(MP + 16 * b) * AP + 64 * hq, 0, 3, act ? 0 : 1, act ? 2 : 0, sk[hq], 0, 0, 0};
            att::attn_unit<0, true>(shm, u, SKVP, SQP, false, false, u, qr);
        }
        {
            const int bh = F.vcu >> 1, b = bh >> 3, h = bh & 7, par = F.vcu & 1, w = F.wave, wl = w >> 1;
            auto descB = [&](int i) { const int pr = i >> 1, od = i & 1; const int qb = 4 * pr + (par == 0 ? (od ? 3 : 0) : (od ? 2 : 1));
                const int tq = 256 * qb + 32 * w, tk0 = 64 * (4 * qb - 8); const int j0 = (8 - 4 * qb) > 0 ? (8 - 4 * qb) : 0;
                return att::AUB{QKV + H_QB + hm_off(8, b, h, 0) + (long)tq * 64, QKV + H_KB + hm_off(8, b, h, 0) + (long)tk0 * 64, QKV + H_VB + hm_off(8, b, h, 0) + (long)tk0 * 64, OB + ((long)b * SEQ + tq) * AP + 512 + 64 * h, j0}; };
            for (int rb_ = 0; rb_ <= (REPEAT_ATT & 1); ++rb_)
            for (int i = 0; i < 8; ++i) att::attn_unit_bw(shm, descB(i), i > 0, i < 7, descB(i < 7 ? i + 1 : i), att::L_BIAS + 260 * 4, 32 * (w & 1), qr);
        }
        {
            const int b = F.vcu >> 4, w = F.wave; const LAS float* sk = (const LAS float*)(F.lds + att::L_SINK);
            auto descA = [&](int i) { const int c = 4 * (F.vcu & 15) + (i >> 1), g = i & 1, hq = 4 * g + (w >> 1);
                const int tq = 64 * c + 32 * (w & 1), tk0 = 64 * (c - 2); const int j0 = (2 - c) > 0 ? (2 - c) : 0;
                return att::AU{QKV + H_QA + hm_off(8, b, hq, 0) + (long)tq * 64, QKV + H_KA + hm_off(2, b, g, 0) + (long)tk0 * 64, QKV + H_VA + hm_off(2, b, g, 0) + (long)tk0 * 64, OB + ((long)b * SEQ + tq) * AP + 64 * hq, j0, 3, j0, 2, sk[hq], 0, 0, 0}; };
            for (int ra_ = 0; ra_ <= ((REPEAT_ATT >> 1) & 1); ++ra_)
            for (int i = 0; i < 8; ++i) att::attn_unit<0, false>(shm, descA(i), 64, 64, i > 0, i < 7, descA(i < 7 ? i + 1 : i), qr);
        }
    }
    GRID_BAR(2);

    if (IN(3)) {
        for (int rs_ = 0; rs_ <= PROBE_SMP; ++rs_) for (int s = F.vcu; s < DM / 16; s += F.G) {
            const int n0 = 16 * s, fr = F.lane & 15, fq = F.lane >> 4;
            const f32x4 aa = skinny(OB + (size_t)MP * AP, AP, Woab_t, AP, n0, F.wave, F.lane, 512, ring), ab = skinny(OB + (size_t)MP * AP + 512, AP, Woab_t + 512, AP, n0, F.wave, F.lane, 512, ring);
#pragma unroll
            for (int reg = 0; reg < 4; ++reg) { const int row = 16 * F.wave + 4 * fq + reg; const float ga = S1[(size_t)row * NIN + 2304 + n0 + fr], gb = S1[(size_t)row * NIN + 3328 + n0 + fr];
                MIX[(size_t)(MP + row) * AP + n0 + fr] = (bf16_t)f2bf(sigmoidf_(ga) * aa[reg] + sigmoidf_(gb) * ab[reg]); }
        }
        pg8::Gemm g{OB, Woab_t, MP, DM, DM, AP, AP}; pg8::StaticOrder S; S.init(MP, DM, F.G, (int)blockIdx.x, 1 + ((REPEAT_MASK >> 3) & 1)); RSYNC(S, 3);
        pg8::EpiGate E{GB, MIX};
        pg8::gemm_phase<pg8::EpiGate, pg8::StaticOrder>(ring, xlds, g, S, E);
    }
    GRID_BAR(3);

    if (IN(4)) {
        for (int rs_ = 0; rs_ <= PROBE_SMP; ++rs_) for (int s = F.vcu; s < DM / 16; s += F.G) {
            const int n0 = 16 * s; const f32x4 acc = skinny(MIX + (size_t)MP * AP, AP, Wout_t, AP, n0, F.wave, F.lane, DM, ring);
            const int fr = F.lane & 15, fq = F.lane >> 4;
#pragma unroll
            for (int reg = 0; reg < 4; ++reg) ZB[(size_t)(MP + 16 * F.wave + 4 * fq + reg) * AP + n0 + fr] = (bf16_t)f2bf(acc[reg]);
        }
        pg8::Gemm g{MIX, Wout_t, MP, DM, DM, AP, AP}; pg8::StaticOrder S; S.init(MP, DM, F.G, (int)blockIdx.x, 1 + ((REPEAT_MASK >> 4) & 1)); RSYNC(S, 4);
        if (PROBE_P4 == 1) { S.sub_n = 4; S.sub_o = 0; } if (PROBE_P4 == 2) { S.sub_n = 4; S.sub_o = 0; g.A2 = XN; }
        pg8::EpiBf16 E{ZB, AP};
        pg8::gemm_phase<pg8::EpiBf16, pg8::StaticOrder>(ring, xlds, g, S, E);
    }
    GRID_BAR(4);

    if (IN(5)) for (int rep_ = 0; rep_ <= ((REPEAT_MASK >> 5) & 1); ++rep_) {
        const float* gpost = F.in[14]; const float* gpre2 = F.in[15];
        for (int m0 = gw; m0 < MP + MS; m0 += 4 * NGW) {
            u32x2 xw[4][4], zw[4][4];
#pragma unroll
            for (int r = 0; r < 4; ++r) { const int m_ = m0 + r * NGW, m = m_ < MP + MS ? m_ : m0; const u32x2* xr = (const u32x2*)(XN + (size_t)m * AP) + F.lane; const u32x2* zr = (const u32x2*)(ZB + (size_t)m * AP) + F.lane;
#pragma unroll
                for (int j = 0; j < 4; ++j) { xw[r][j] = xr[64 * j]; zw[r][j] = zr[64 * j]; } }
            __builtin_amdgcn_sched_barrier(0);
#pragma unroll
            for (int r = 0; r < 4; ++r) { const int m = m0 + r * NGW; if (m >= MP + MS) break;
                f32x4 z[4], x[4]; float s = 0.f;
#pragma unroll
                for (int j = 0; j < 4; ++j) { const u32x2 w = zw[r][j]; z[j] = (f32x4){bf_lo(w.x), bf_hi(w.x), bf_lo(w.y), bf_hi(w.y)}; s += (z[j].x * z[j].x + z[j].y * z[j].y) + (z[j].z * z[j].z + z[j].w * z[j].w); }
                const float rz = 1.0f / sqrtf(wave_sum(s) * (1.f / DM) + EPS); float s1 = 0.f;
#pragma unroll
                for (int j = 0; j < 4; ++j) { const u32x2 w = xw[r][j]; const f32x4 gg = ((const f32x4*)gpost)[F.lane + 64 * j]; x[j] = (f32x4){bf_lo(w.x), bf_hi(w.x), bf_lo(w.y), bf_hi(w.y)} + z[j] * rz * gg;
                    s1 += (x[j].x * x[j].x + x[j].y * x[j].y) + (x[j].z * x[j].z + x[j].w * x[j].w); }
                const float r1 = 1.0f / sqrtf(wave_sum(s1) * (1.f / DM) + EPS);
                if (F.lane == 0) RSTD1[m] = r1;
                unsigned long long* yo = (unsigned long long*)(X1B + (size_t)m * AP) + F.lane;
#pragma unroll
                for (int j = 0; j < 4; ++j) yo[64 * j] = (unsigned long long)pk2(x[j].x, x[j].y) | ((unsigned long long)pk2(x[j].z, x[j].w) << 32); }
        }
    }
    GRID_BAR(5);

    if (IN(6)) {
        const float* cw = F.in[17]; const float* cb = F.in[18]; const float* stc = F.in[6];
        for (int rs_ = 0; rs_ <= PROBE_SMP; ++rs_) for (int s = F.vcu; s < FF / 16; s += F.G) {
            const int c0 = 16 * s, nu = 256 * (c0 >> 7) + (c0 & 127), fr = F.lane & 15, fq = F.lane >> 4, b = F.wave, col = c0 + fr;
            f32x4 au = skinny(X1B + (size_t)MP * AP, AP, Wup_t, AP, nu, F.wave, F.lane, DM, ring), av = skinny(X1B + (size_t)MP * AP, AP, Wup_t, AP, nu + 128, F.wave, F.lane, DM, ring);
#pragma unroll
            for (int reg = 0; reg < 4; ++reg) { const float rs = RSTD1[MP + 16 * b + 4 * fq + reg]; au[reg] *= rs; av[reg] *= rs; }
            const float up3 = __shfl_up(au[3], 16), up2 = __shfl_up(au[2], 16);
            const float sc0 = stc[((size_t)b * 2 + 0) * FF + col], sc1 = stc[((size_t)b * 2 + 1) * FF + col];
            const float m1 = (fq == 0) ? sc1 : up3, m2 = (fq == 0) ? sc0 : up2;
            const float w0 = cw[col], w1 = cw[FF + col], w2 = cw[2 * FF + col], bz = cb[col];
            float uu[6] = {m2, m1, au[0], au[1], au[2], au[3]};
#pragma unroll
            for (int reg = 0; reg < 4; ++reg) { const float cv = bz + w0 * uu[reg] + w1 * uu[reg + 1] + w2 * uu[reg + 2];
                GT[(size_t)(MP + 16 * b + 4 * fq + reg) * GTP + col] = (bf16_t)f2bf(gelu1(cv) * av[reg]); }
            if (fq == 3) { F.out[O_CVS + ((size_t)b * 2 + 0) * FF + col] = au[2]; F.out[O_CVS + ((size_t)b * 2 + 1) * FF + col] = au[3]; }
        }
        pg8::Gemm g{X1B, Wup_t, MP, NUP, DM, AP, AP}; pg8::StaticOrder S; S.init(MP, NUP, F.G, (int)blockIdx.x, 1 + ((REPEAT_MASK >> 6) & 1)); RSYNC(S, 6);
        pg8::EpiUp E{GT, cw, cb, uhalo, fixu, fixv, F.out, RSTD1};
        pg8::gemm_phase<pg8::EpiUp, pg8::StaticOrder>(ring, xlds, g, S, E);
    }
    GRID_BAR(6);

    if (IN(7)) {
        const float* cw = F.in[17]; const float* cb = F.in[18];
        pg8::StaticOrder S; S.init(MP, DM, F.G, (int)blockIdx.x, 1 + ((REPEAT_MASK >> 7) & 1)); RSYNC(S, 7);
        { pg8::Unit u;
          for (int i = 0; S.next(i, u); ++i) {
              const int pm = u.pm; if ((pm & 15) == 0) continue;
              for (int e = F.tid; e < 2 * FF; e += 512) { const int j = e / FF, c = e % FF;
                  const float hm2 = uhalo[((size_t)(pm - 1) * 2 + 0) * FF + c], hm1 = uhalo[((size_t)(pm - 1) * 2 + 1) * FF + c];
                  const float u0 = fixu[((size_t)pm * 2 + 0) * FF + c], u1 = fixu[((size_t)pm * 2 + 1) * FF + c], vv = fixv[((size_t)pm * 2 + j) * FF + c];
                  const float p2 = j == 0 ? hm2 : hm1, p1 = j == 0 ? hm1 : u0, cur = j == 0 ? u0 : u1;
                  const float cv = cb[c] + cw[c] * p2 + cw[FF + c] * p1 + cw[2 * FF + c] * cur;
                  GT[(size_t)(pm * 256 + j) * GTP + c] = (bf16_t)f2bf(gelu1(cv) * vv); }
          }
          VM_WAIT(); __syncthreads(); }
        for (int rs_ = 0; rs_ <= PROBE_SMP; ++rs_) for (int s = F.vcu; s < DM / 16; s += F.G) {
            const int n0 = 16 * s; const f32x4 acc = skinny(GT + (size_t)MP * GTP, GTP, Wd_t, GTP, n0, F.wave, F.lane, FF, ring);
            const int fr = F.lane & 15, fq = F.lane >> 4;
#pragma unroll
            for (int reg = 0; reg < 4; ++reg) FB[(size_t)(MP + 16 * F.wave + 4 * fq + reg) * AP + n0 + fr] = (bf16_t)f2bf(acc[reg]);
        }
        pg8::Gemm g{GT, Wd_t, MP, DM, FF, GTP, GTP};
        pg8::EpiBf16 E{FB, AP};
        pg8::gemm_phase<pg8::EpiBf16, pg8::StaticOrder>(ring, xlds, g, S, E);
    }
    GRID_BAR(7);

    if (IN(8)) for (int rep_ = 0; rep_ <= ((REPEAT_MASK >> 8) & 1); ++rep_) {
        const float* gp = F.in[20];
        for (int m0 = gw; m0 < MP + MS; m0 += 4 * NGW) {
            u32x2 xw[4][4], fw[4][4];
#pragma unroll
            for (int r = 0; r < 4; ++r) { const int m_ = m0 + r * NGW, m = m_ < MP + MS ? m_ : m0; const u32x2* fr_ = (const u32x2*)(FB + (size_t)m * AP) + F.lane; const u32x2* xr_ = (const u32x2*)(X1B + (size_t)m * AP) + F.lane;
#pragma unroll
                for (int j = 0; j < 4; ++j) { xw[r][j] = xr_[64 * j]; fw[r][j] = fr_[64 * j]; } }
            __builtin_amdgcn_sched_barrier(0);
#pragma unroll
            for (int r = 0; r < 4; ++r) { const int m = m0 + r * NGW; if (m >= MP + MS) break;
                f32x4 z[4]; float s = 0.f;
#pragma unroll
                for (int j = 0; j < 4; ++j) { const u32x2 w = fw[r][j]; z[j] = (f32x4){bf_lo(w.x), bf_hi(w.x), bf_lo(w.y), bf_hi(w.y)}; s += (z[j].x * z[j].x + z[j].y * z[j].y) + (z[j].z * z[j].z + z[j].w * z[j].w); }
                const float rz = 1.0f / sqrtf(wave_sum(s) * (1.f / DM) + EPS);
                f32x4* yr = (f32x4*)yrow_ptr(F, m) + F.lane;
#pragma unroll
                for (int j = 0; j < 4; ++j) { const u32x2 w = xw[r][j]; const f32x4 x = (f32x4){bf_lo(w.x), bf_hi(w.x), bf_lo(w.y), bf_hi(w.y)}; const f32x4 gg = ((const f32x4*)gp)[F.lane + 64 * j]; yr[64 * j] = x + z[j] * rz * gg; } }
        }
    }
    if (one_launch) for (int xb_ = 0; xb_ < PROBE_XBAR; ++xb_) xcd_barrier(bar);
#undef IN
#undef GRID_BAR
}

#ifndef MK_PER_PHASE
#define MK_PER_PHASE 0
#endif
extern "C" void kernel_launch(void* const* d_in, const int* in_sizes, int n_in, void* d_out, int out_size, void* d_ws, size_t ws_size, hipStream_t stream) {
    static int grid = 0;
    if (grid == 0) {
        if (n_in != 21 || (size_t)out_size != O_END || ws_size < WS_END) { fprintf(stderr, "kernel_launch: unexpected shapes n_in %d out %d ws %zu\n", n_in, out_size, ws_size); grid = -1; return; }
        int dev = 0, cus = 0;
        if (hipGetDevice(&dev) != hipSuccess || hipDeviceGetAttribute(&cus, hipDeviceAttributeMultiprocessorCount, dev) != hipSuccess) { grid = -1; return; }
        if (hipFuncSetAttribute((const void*)fwd_kernel, hipFuncAttributeMaxDynamicSharedMemorySize, LDS_BYTES) != hipSuccess) { fprintf(stderr, "kernel_launch: hipFuncSetAttribute failed\n"); grid = -1; return; }
        (void)hipGetLastError();
        grid = cus;
    }
    if (grid < 0) return;
    (void)hipMemsetAsync((char*)d_ws + WS_CTL, 0, CTL_ZERO_BYTES, stream);
    Args a{};
    for (int i = 0; i < 21; ++i) a.in[i] = (const float*)d_in[i];
    a.out = (float*)d_out; a.ws = (unsigned char*)d_ws;
#if MK_PER_PHASE
    for (int p = 0; p < 9; ++p) { a.ph_lo = p; a.ph_hi = p + 1; hipLaunchKernelGGL(fwd_kernel, dim3(grid), dim3(512), LDS_BYTES, stream, a); }
#else
    a.ph_lo = 0; a.ph_hi = 9;
    hipLaunchKernelGGL(fwd_kernel, dim3(grid), dim3(512), LDS_BYTES, stream, a);
#endif
}
```
